# Optimizing an MI355X kernel written in HIP

```python
import math
import jax, jax.numpy as jnp
from jax import lax
import numpy as np

D_MODEL = 1024
BATCH = 4
SEQ = 4096
DEPTH = 4
DEC_BATCH = 8
DEC_SEQ = 16
PAST_LEN = 4096

CHUNK = 64
N_EVEN = (DEPTH + 1) // 2
N_ODD = DEPTH // 2
D_FF = 2816
NORM_EPS = 1e-6
POOL_WINDOWS = (2, 4, 8, 16)
N_POOL_GROUPS = len(POOL_WINDOWS)
C_POOL = D_MODEL // 2
POOL_GC = C_POOL // N_POOL_GROUPS
POOL_HIST = max(POOL_WINDOWS) - 1
HEAD_DIM = 64
N_Q_HEADS = (D_MODEL // 2) // HEAD_DIM
N_KV_HEADS = N_Q_HEADS // 4
GQA_GROUP = N_Q_HEADS // N_KV_HEADS
WINDOW = 128
BACK_CHUNKS = WINDOW // CHUNK
SWA_ROWS = WINDOW
Q_W = N_Q_HEADS * HEAD_DIM
KV_W = N_KV_HEADS * HEAD_DIM
IN_EVEN = C_POOL + Q_W + 2 * KV_W
OUT_EVEN = C_POOL + Q_W
N_BUCKETS = 32
MAX_DISTANCE = 128
RWKV_HEAD = 64
RWKV_H = D_MODEL // RWKV_HEAD
DECAY_LORA = 64
AAA_LORA = 64
GATE_LORA = 128
LNX_EPS = 64e-5

kernel_name = 'hybrid_stream_pool_swa_rwkv7_step'


def rmsnorm(x, g):
    x32 = x.astype(jnp.float32)
    y = x32 * lax.rsqrt(jnp.mean(x32 * x32, axis=-1, keepdims=True) + NORM_EPS)
    return (y * g.astype(jnp.float32)).astype(x.dtype)


def swiglu(h, wg, wu, wd):
    return (jax.nn.silu(h @ wg) * (h @ wu)) @ wd


def t5_bucket(rel):
    half = N_BUCKETS // 2
    max_exact = half // 2
    side = jnp.where(rel > 0, half, 0)
    n = jnp.abs(rel)
    nf = jnp.maximum(n, max_exact).astype(jnp.float32)
    large = max_exact + (jnp.log(nf / max_exact) / math.log(MAX_DISTANCE / max_exact)
                         * (half - max_exact)).astype(jnp.int32)
    large = jnp.minimum(large, half - 1)
    return side + jnp.where(n < max_exact, n, large)


def rel_bias(table, lq, lk, offset):
    rel = jnp.arange(lk)[None, :] - offset - jnp.arange(lq)[:, None]
    b = table.astype(jnp.float32)[t5_bucket(rel)]
    return jnp.transpose(b, (2, 0, 1)).reshape(N_KV_HEADS, GQA_GROUP, lq, lk)


def sink_attention(q, k, v, bias, sinks, valid):
    s = jnp.einsum('...qhgd,...khd->...hgqk', q, k).astype(jnp.float32) * (HEAD_DIM ** -0.5) + bias
    if valid is not None:
        s = jnp.where(valid, s, -1e30)
    sink = sinks.astype(jnp.float32)[:, :, None, None]
    m = jnp.maximum(jnp.max(s, axis=-1, keepdims=True), sink)
    p = jnp.exp(s - m)
    p = p / (jnp.sum(p, axis=-1, keepdims=True) + jnp.exp(sink - m))
    return jnp.einsum('...hgqk,...khd->...qhgd', p.astype(v.dtype), v)


def pool_mix(u, hist, pos0, pool_w, pool_scale):
    B, L, _ = u.shape
    full = jnp.concatenate([hist.astype(u.dtype), u], axis=1).astype(jnp.float32)
    cs = jnp.concatenate([jnp.zeros((B, 1, C_POOL), jnp.float32), jnp.cumsum(full, axis=1)], axis=1)
    end = cs[:, POOL_HIST + 1:]
    t = pos0 + jnp.arange(L)
    means = []
    for gi, w in enumerate(POOL_WINDOWS):
        sl = slice(gi * POOL_GC, (gi + 1) * POOL_GC)
        start = cs[:, POOL_HIST + 1 - w: POOL_HIST + 1 - w + L, sl]
        cnt = jnp.minimum(w, t + 1).astype(jnp.float32)[None, :, None]
        means.append((end[..., sl] - start) / cnt)
    pooled = jnp.concatenate(means, axis=-1) - full[:, POOL_HIST:]
    pooled = pooled.astype(u.dtype).reshape(B, L, N_POOL_GROUPS, POOL_GC)
    out = jnp.einsum('blgc,gcd->blgd', pooled, pool_w).reshape(B, L, C_POOL) * pool_scale
    return out, full[:, -POOL_HIST:].astype(u.dtype)


def even_mixer(h, pos0, pool_hist, k_hist, v_hist, w_in, pool_w, pool_scale, sinks, t5_table, w_out):
    B, L, _ = h.shape
    z = h @ w_in
    u = z[..., :C_POOL]
    q = z[..., C_POOL:C_POOL + Q_W].reshape(B, L, N_KV_HEADS, GQA_GROUP, HEAD_DIM)
    k = z[..., C_POOL + Q_W:C_POOL + Q_W + KV_W].reshape(B, L, N_KV_HEADS, HEAD_DIM)
    v = z[..., C_POOL + Q_W + KV_W:].reshape(B, L, N_KV_HEADS, HEAD_DIM)
    pool_out, new_pool = pool_mix(u, pool_hist, pos0, pool_w, pool_scale)
    sink = sinks.reshape(N_KV_HEADS, GQA_GROUP)
    if k_hist is None:
        n_c = L // CHUNK
        band = (BACK_CHUNKS + 1) * CHUNK
        qc = q.reshape(B, n_c, CHUNK, N_KV_HEADS, GQA_GROUP, HEAD_DIM)
        pad = ((0, 0), (BACK_CHUNKS, 0), (0, 0), (0, 0), (0, 0))
        kc = jnp.pad(k.reshape(B, n_c, CHUNK, N_KV_HEADS, HEAD_DIM), pad)
        vc = jnp.pad(v.reshape(B, n_c, CHUNK, N_KV_HEADS, HEAD_DIM), pad)
        kb = jnp.concatenate([kc[:, j:j + n_c] for j in range(BACK_CHUNKS + 1)], axis=2)
        vb = jnp.concatenate([vc[:, j:j + n_c] for j in range(BACK_CHUNKS + 1)], axis=2)
        kpos = (jnp.arange(n_c) * CHUNK)[:, None] - BACK_CHUNKS * CHUNK + jnp.arange(band)[None, :]
        valid = (kpos >= 0)[None, :, None, None, None, :]
        bias = rel_bias(t5_table, CHUNK, band, BACK_CHUNKS * CHUNK)
        att = sink_attention(qc, kb, vb, bias, sink, valid)
        k_all, v_all = k, v
    else:
        k_all = jnp.concatenate([k_hist.astype(k.dtype), k], axis=1)
        v_all = jnp.concatenate([v_hist.astype(v.dtype), v], axis=1)
        bias = rel_bias(t5_table, L, SWA_ROWS + L, SWA_ROWS)
        att = sink_attention(q, k_all, v_all, bias, sink, None)
    att = att.reshape(B, L, Q_W)
    out = jnp.concatenate([pool_out, att], axis=-1) @ w_out
    return out, new_pool, k_all[:, -SWA_ROWS:], v_all[:, -SWA_ROWS:]


def rwkv7_step(S, inp):
    r_t, w_t, k_t, v_t, kk_t, a_t = inp
    sa = jnp.einsum('bhij,bhj->bhi', S, -kk_t)
    S = S * w_t[:, :, None, :] + sa[..., :, None] * (kk_t * a_t)[..., None, :] + v_t[..., :, None] * k_t[..., None, :]
    return S, jnp.einsum('bhij,bhj->bhi', S, r_t)


def rwkv7_time_mix(h, shift_prev, S0, mu, wr, wk, wv, w0, w1, w2, a0, a1, a2, g1, g2,
                   k_k, k_a, r_k, lnx_w, lnx_b, wo):
    B, L, D = h.shape
    f32 = jnp.float32
    h_prev = jnp.concatenate([shift_prev[:, None, :].astype(h.dtype), h[:, :-1]], axis=1)
    xx = h_prev - h
    xr, xw, xk, xv, xa, xg = (h + xx * mu[j] for j in range(6))
    r = xr @ wr
    k = xk @ wk
    v = xv @ wv
    w = -jax.nn.softplus(-(w0 + jnp.tanh(xw @ w1) @ w2).astype(f32)) - 0.5
    a = jax.nn.sigmoid((a0 + (xa @ a1) @ a2).astype(f32))
    g = jax.nn.sigmoid(xg @ g1) @ g2
    heads = lambda t: t.astype(f32).reshape(B, L, RWKV_H, RWKV_HEAD)
    r, k, v, w, a = heads(r), heads(k), heads(v), heads(w), heads(a)
    kk = k * k_k.astype(f32).reshape(RWKV_H, RWKV_HEAD)
    kk = kk * lax.rsqrt(jnp.maximum(jnp.sum(kk * kk, axis=-1, keepdims=True), 1e-24))
    k = k * (1.0 + (a - 1.0) * k_a.astype(f32).reshape(RWKV_H, RWKV_HEAD))
    decay = jnp.exp(-jnp.exp(w))
    xs = tuple(jnp.moveaxis(t, 1, 0) for t in (r, decay, k, v, kk, a))
    S_fin, ys = lax.scan(rwkv7_step, S0.astype(f32), xs)
    y = jnp.moveaxis(ys, 0, 1)
    mean = jnp.mean(y, axis=-1, keepdims=True)
    var = jnp.mean(jnp.square(y - mean), axis=-1, keepdims=True)
    yn = ((y - mean) * lax.rsqrt(var + LNX_EPS)).reshape(B, L, D) * lnx_w.astype(f32) + lnx_b.astype(f32)
    bonus = (jnp.sum(r * k * r_k.astype(f32), axis=-1, keepdims=True) * v).reshape(B, L, D)
    out = ((yn + bonus).astype(h.dtype) * g) @ wo
    return out, h[:, -1], S_fin.astype(h.dtype)


def trunk(x, pos0, caches, p):
    pool_c, k_c, v_c, shift_c, wkv_c = caches
    B = x.shape[0]
    new_pool, new_k, new_v, new_shift, new_wkv = [], [], [], [], []
    for l in range(DEPTH):
        x = x + 0.5 * swiglu(rmsnorm(x, p['norm_ffn'][l, 0]), p['ffn_w_gate'][l, 0],
                             p['ffn_w_up'][l, 0], p['ffn_w_down'][l, 0])
        h = rmsnorm(x, p['norm_mix'][l])
        i = l // 2
        if l % 2 == 0:
            hist = jnp.zeros((B, POOL_HIST, C_POOL), x.dtype) if pool_c is None else pool_c[i]
            out, pc, kc, vc = even_mixer(h, pos0, hist,
                                         None if k_c is None else k_c[i],
                                         None if v_c is None else v_c[i],
                                         p['w_in_even'][i], p['pool_w'][i], p['pool_scale'][i],
                                         p['attn_sinks'][i], p['t5_table'], p['w_out_even'][i])
            new_pool.append(pc)
            new_k.append(kc)
            new_v.append(vc)
        else:
            sh = jnp.zeros((B, D_MODEL), x.dtype) if shift_c is None else shift_c[i]
            S0 = jnp.zeros((B, RWKV_H, RWKV_HEAD, RWKV_HEAD), jnp.float32) if wkv_c is None else wkv_c[i]
            out, sh_new, S_new = rwkv7_time_mix(
                h, sh, S0, p['rwkv_mu'][i], p['rwkv_wr'][i], p['rwkv_wk'][i], p['rwkv_wv'][i],
                p['rwkv_w0'][i], p['rwkv_w1'][i], p['rwkv_w2'][i], p['rwkv_a0'][i], p['rwkv_a1'][i],
                p['rwkv_a2'][i], p['rwkv_g1'][i], p['rwkv_g2'][i], p['rwkv_k_k'][i], p['rwkv_k_a'][i],
                p['rwkv_r_k'][i], p['rwkv_lnx_w'][i], p['rwkv_lnx_b'][i], p['rwkv_wo'][i])
            new_shift.append(sh_new)
            new_wkv.append(S_new)
        x = x + out
        x = x + 0.5 * swiglu(rmsnorm(x, p['norm_ffn'][l, 1]), p['ffn_w_gate'][l, 1],
                             p['ffn_w_up'][l, 1], p['ffn_w_down'][l, 1])
    y = rmsnorm(x, p['norm_final'])
    return (y, jnp.stack(new_pool), jnp.stack(new_k), jnp.stack(new_v),
            jnp.stack(new_shift), jnp.stack(new_wkv))


def setup_inputs(seed: int = 0) -> dict:
    key = jax.random.key(seed)
    ks = iter(jax.random.split(key, 40))
    f32 = jnp.float32
    D = D_MODEL

    def nrm(shape, scale):
        return jax.random.normal(next(ks), shape, f32) * scale

    def unif(shape, lo, hi):
        return jax.random.uniform(next(ks), shape, f32, lo, hi)

    return {
        'x_prompt': nrm((BATCH, SEQ, D), 1.0),
        'x_sample': nrm((DEC_BATCH, DEC_SEQ, D), 1.0),
        'cache_pool': nrm((N_EVEN, DEC_BATCH, POOL_HIST, C_POOL), 1.0),
        'cache_swa_k': nrm((N_EVEN, DEC_BATCH, SWA_ROWS, N_KV_HEADS, HEAD_DIM), 1.0),
        'cache_swa_v': nrm((N_EVEN, DEC_BATCH, SWA_ROWS, N_KV_HEADS, HEAD_DIM), 1.0),
        'state_shift': nrm((N_ODD, DEC_BATCH, D), 1.0),
        'state_wkv': nrm((N_ODD, DEC_BATCH, RWKV_H, RWKV_HEAD, RWKV_HEAD), 1.0),
        't5_table': nrm((N_BUCKETS, N_Q_HEADS), 0.5),
        'norm_ffn': 1.0 + nrm((DEPTH, 2, D), 0.02),
        'ffn_w_gate': nrm((DEPTH, 2, D, D_FF), D ** -0.5),
        'ffn_w_up': nrm((DEPTH, 2, D, D_FF), D ** -0.5),
        'ffn_w_down': nrm((DEPTH, 2, D_FF, D), D_FF ** -0.5),
        'norm_mix': 1.0 + nrm((DEPTH, D), 0.02),
        'w_in_even': nrm((N_EVEN, D, IN_EVEN), D ** -0.5),
        'pool_w': nrm((N_EVEN, N_POOL_GROUPS, POOL_GC, POOL_GC), POOL_GC ** -0.5),
        'pool_scale': 1.0 + nrm((N_EVEN, C_POOL), 0.1),
        'attn_sinks': nrm((N_EVEN, N_Q_HEADS), 0.5),
        'w_out_even': nrm((N_EVEN, OUT_EVEN, D), OUT_EVEN ** -0.5),
        'rwkv_mu': unif((N_ODD, 6, D), 0.0, 1.0),
        'rwkv_wr': nrm((N_ODD, D, D), D ** -0.5),
        'rwkv_wk': nrm((N_ODD, D, D), D ** -0.5),
        'rwkv_wv': nrm((N_ODD, D, D), D ** -0.5),
        'rwkv_w0': unif((N_ODD, D), -5.0, 0.5),
        'rwkv_w1': nrm((N_ODD, D, DECAY_LORA), D ** -0.5),
        'rwkv_w2': nrm((N_ODD, DECAY_LORA, D), 0.1 * DECAY_LORA ** -0.5),
        'rwkv_a0': nrm((N_ODD, D), 0.1),
        'rwkv_a1': nrm((N_ODD, D, AAA_LORA), D ** -0.5),
        'rwkv_a2': nrm((N_ODD, AAA_LORA, D), 0.1 * AAA_LORA ** -0.5),
        'rwkv_g1': nrm((N_ODD, D, GATE_LORA), D ** -0.5),
        'rwkv_g2': nrm((N_ODD, GATE_LORA, D), GATE_LORA ** -0.5),
        'rwkv_k_k': 0.85 + nrm((N_ODD, D), 0.05),
        'rwkv_k_a': 1.0 + nrm((N_ODD, D), 0.05),
        'rwkv_r_k': nrm((N_ODD, RWKV_H, RWKV_HEAD), 0.1),
        'rwkv_lnx_w': 1.0 + nrm((N_ODD, D), 0.02),
        'rwkv_lnx_b': nrm((N_ODD, D), 0.02),
        'rwkv_wo': nrm((N_ODD, D, D), D ** -0.5),
        'norm_final': 1.0 + nrm((D,), 0.02),
    }


def reference(x_prompt, x_sample, cache_pool, cache_swa_k, cache_swa_v, state_shift, state_wkv,
              t5_table, norm_ffn, ffn_w_gate, ffn_w_up, ffn_w_down, norm_mix,
              w_in_even, pool_w, pool_scale, attn_sinks, w_out_even,
              rwkv_mu, rwkv_wr, rwkv_wk, rwkv_wv, rwkv_w0, rwkv_w1, rwkv_w2,
              rwkv_a0, rwkv_a1, rwkv_a2, rwkv_g1, rwkv_g2, rwkv_k_k, rwkv_k_a, rwkv_r_k,
              rwkv_lnx_w, rwkv_lnx_b, rwkv_wo, norm_final):
    p = dict(t5_table=t5_table, norm_ffn=norm_ffn, ffn_w_gate=ffn_w_gate, ffn_w_up=ffn_w_up,
             ffn_w_down=ffn_w_down, norm_mix=norm_mix, w_in_even=w_in_even, pool_w=pool_w,
             pool_scale=pool_scale, attn_sinks=attn_sinks, w_out_even=w_out_even,
             rwkv_mu=rwkv_mu, rwkv_wr=rwkv_wr, rwkv_wk=rwkv_wk, rwkv_wv=rwkv_wv,
             rwkv_w0=rwkv_w0, rwkv_w1=rwkv_w1, rwkv_w2=rwkv_w2, rwkv_a0=rwkv_a0, rwkv_a1=rwkv_a1,
             rwkv_a2=rwkv_a2, rwkv_g1=rwkv_g1, rwkv_g2=rwkv_g2, rwkv_k_k=rwkv_k_k, rwkv_k_a=rwkv_k_a,
             rwkv_r_k=rwkv_r_k, rwkv_lnx_w=rwkv_lnx_w, rwkv_lnx_b=rwkv_lnx_b, rwkv_wo=rwkv_wo,
             norm_final=norm_final)
    y_prompt, pool_p, k_p, v_p, shift_p, wkv_p = trunk(x_prompt, 0, (None, None, None, None, None), p)
    y_sample, pool_s, k_s, v_s, shift_s, wkv_s = trunk(
        x_sample, PAST_LEN, (cache_pool, cache_swa_k, cache_swa_v, state_shift, state_wkv), p)
    return (y_prompt, y_sample, pool_p, pool_s, k_p, k_s, v_p, v_s, shift_p, shift_s, wkv_p, wkv_s)
```

```cpp
#include <hip/hip_runtime.h>
#include <hip/hip_cooperative_groups.h>
#include <cstdio>
#include <cstdint>
namespace cg = cooperative_groups;
namespace pg8 {
#define PG8_LAS __attribute__((address_space(3)))
typedef unsigned short bf16_t;
typedef short bf16x8 __attribute__((ext_vector_type(8)));
typedef float f32x4 __attribute__((ext_vector_type(4)));
typedef unsigned u32x4 __attribute__((ext_vector_type(4)));
constexpr int BM = 256, BK = 64, HALF = 128, HTB = HALF * BK * 2  , STAGE_BYTES = 8 * HTB, NXCD = 8, WGM = 8;

__host__ __device__ __forceinline__ int lds_byte(int r, int c) { const int st = (r >> 4) * 2 + (c >> 5), rr = r & 15, cc = c & 31, ob = rr * 64 + cc * 2; return st * 1024 + (ob ^ (((ob >> 9) & 1) << 5)); }
__host__ __device__ __forceinline__ void stage_rc(int b, int& R, int& C) { const int st = b / 1024, sb = b % 1024, swz = sb ^ (((sb >> 9) & 1) << 5); R = (st >> 1) * 16 + swz / 64; C = (st & 1) * 32 + (swz % 64) / 2; }
__host__ __device__ __forceinline__ int perm32(int rho) { const int n = rho >> 4, i = rho & 15; return 8 * (i >> 2) + 4 * n + (i & 3); }

struct Unit { int pm, pn; };
struct Gemm { const bf16_t* A; const bf16_t* Bt; int M, N, K; };

struct StaticOrder {
    int nM, nN, nwg, G, c;
    __host__ __device__ void init(int M, int N, int G_, int c_) { nM = M / BM; nN = N / BM; nwg = nM * nN; G = G_; c = c_; }
    __host__ __device__ bool next(int i, Unit& u) const {
        const long L = (long)i * G + c; if (L >= nwg) return false;
        int wgid = (int)L; { const int q = nwg / NXCD, r = nwg % NXCD, xcd = wgid % NXCD, off = wgid / NXCD; wgid = (xcd < r ? xcd * (q + 1) : r * (q + 1) + (xcd - r) * q) + off; }
        const int nig = WGM * nN, gid = wgid / nig, fm = gid * WGM, gsz = (nM - fm) < WGM ? (nM - fm) : WGM;
        u.pm = fm + ((wgid % nig) % gsz); u.pn = (wgid % nig) / gsz; return true;
    }
    __device__ __forceinline__ void a_ready(const Unit&) const {}
    __device__ __forceinline__ void done(const Unit&) const {}
};

typedef float f32x2 __attribute__((ext_vector_type(2)));
template <class Epi, class Sched, bool ALIGN_EPI = false, bool SP2 = false>
__device__ __forceinline__ void gemm_phase(PG8_LAS unsigned char* lds, const Gemm g, const Sched& S, const Epi& E, int tid_in) {
    int tid_ = tid_in; asm volatile("" : "+v"(tid_));
    const int tid = tid_, wid = __builtin_amdgcn_readfirstlane(tid >> 6), lane = tid & 63, wr = wid >> 2, wc = wid & 3, fr = lane & 15, fq = lane >> 4;
    const int K = g.K, nt = K / BK;
    unsigned voffA[2], voffB[2];
#pragma unroll
    for (int i = 0; i < 2; ++i) { int R, C; stage_rc(tid * 16 + i * 8192, R, C); const int Rb = Epi::PERM ? ((R & ~31) + perm32(R & 31)) : R;
        voffA[i] = (unsigned)(R * K + C) * 2u; voffB[i] = (unsigned)(Rb * K + C) * 2u; }
    const size_t kstep = (size_t)(BK * 2);
    const size_t hstep = (size_t)HALF * K * 2;
    const size_t tstep = 2 * hstep;
    const unsigned ldsw = (unsigned)wid * 1024u;
    const int aoff = lds_byte(wr * 64 + fr, fq * 8), boff = lds_byte(wc * 32 + fr, fq * 8);
#define PG8_SA(b, h) (((b) * 2 + (h)) * HTB)
#define PG8_SB(b, h) ((4 + (b) * 2 + (h)) * HTB)
#define PG8_STAGE(bufoff, gbase, voff) do { _Pragma("unroll") for (int _i = 0; _i < 2; ++_i) \
        __builtin_amdgcn_global_load_lds((const unsigned*)((const char*)(gbase) + (voff)[_i]), (PG8_LAS unsigned*)(lds + (bufoff) + ldsw + _i * 8192), 16, 0, 0); } while (0)
#define PG8_LDA(dst, b, h) do { _Pragma("unroll") for (int m = 0; m < 4; ++m) _Pragma("unroll") for (int k = 0; k < 2; ++k) dst[m][k] = *(const PG8_LAS bf16x8*)(lds + PG8_SA(b, h) + aoff + m * 2048 + k * 1024); } while (0)
#define PG8_LDB(dst, b, h) do { _Pragma("unroll") for (int n = 0; n < 2; ++n) _Pragma("unroll") for (int k = 0; k < 2; ++k) dst[n][k] = *(const PG8_LAS bf16x8*)(lds + PG8_SB(b, h) + boff + n * 2048 + k * 1024); } while (0)
#define PG8_MMA(ai, bj, At, Bt) do { __builtin_amdgcn_s_setprio(1); _Pragma("unroll") for (int m = 0; m < 4; ++m) _Pragma("unroll") for (int n = 0; n < 2; ++n) _Pragma("unroll") for (int k = 0; k < 2; ++k) \
        acc[ai][bj][m][n] = __builtin_amdgcn_mfma_f32_16x16x32_bf16(Bt[n][k], At[m][k], acc[ai][bj][m][n], 0, 0, 0); __builtin_amdgcn_s_setprio(0); } while (0)
#define PG8_WAIT_V(n) asm volatile("s_waitcnt vmcnt(" #n ")" ::: "memory")
#define PG8_WAIT_L(n) asm volatile("s_waitcnt lgkmcnt(" #n ")" ::: "memory")
#define PG8_BAR __builtin_amdgcn_s_barrier()
#define PG8_SCHED __builtin_amdgcn_sched_barrier(0)
    Unit cur, nxt; int ui = 0;
    if (!S.next(0, cur)) return;
    f32x4 acc[2][2][4][2];
#pragma unroll
    for (int a = 0; a < 2; ++a)
#pragma unroll
        for (int b = 0; b < 2; ++b)
#pragma unroll
            for (int m = 0; m < 4; ++m)
#pragma unroll
                for (int n = 0; n < 2; ++n) acc[a][b][m][n] = (f32x4){0.f, 0.f, 0.f, 0.f};
    bf16x8 At[4][2], B0[2][2], B1[2][2];
    const char* cA = (const char*)g.A + (size_t)cur.pm * tstep; const char* cB = (const char*)g.Bt + (size_t)cur.pn * tstep;
    S.a_ready(cur);
    if constexpr (SP2) {
        PG8_STAGE(PG8_SB(0, 0), cB, voffB); PG8_STAGE(PG8_SB(0, 1), cB + hstep, voffB); PG8_STAGE(PG8_SA(0, 0), cA, voffA); PG8_STAGE(PG8_SA(0, 1), cA + hstep, voffA);
        if (wr == 1) PG8_BAR;
        PG8_WAIT_V(2); PG8_BAR;
        PG8_STAGE(PG8_SB(1, 0), cB + kstep, voffB); PG8_STAGE(PG8_SA(1, 0), cA + kstep, voffA); PG8_STAGE(PG8_SB(1, 1), cB + hstep + kstep, voffB);
        PG8_WAIT_V(6); PG8_BAR;
    } else {
        PG8_STAGE(PG8_SB(0, 0), cB, voffB); PG8_STAGE(PG8_SA(0, 0), cA, voffA); PG8_STAGE(PG8_SB(0, 1), cB + hstep, voffB); PG8_STAGE(PG8_SA(0, 1), cA + hstep, voffA);
        if (wr == 1) PG8_BAR;
        PG8_WAIT_V(4); PG8_BAR;
        PG8_STAGE(PG8_SB(1, 0), cB + kstep, voffB); PG8_STAGE(PG8_SA(1, 0), cA + kstep, voffA); PG8_STAGE(PG8_SB(1, 1), cB + hstep + kstep, voffB);
        PG8_WAIT_V(6); PG8_BAR;
    }
    for (;;) {
        const bool has_next = S.next(ui + 1, nxt);
        const char* nA = has_next ? (const char*)g.A + (size_t)nxt.pm * tstep : cA; const char* nB = has_next ? (const char*)g.Bt + (size_t)nxt.pn * tstep : cB;
        for (int t = 0; t < nt; t += 2) {
            const bool last = (t == nt - 2);
            const char* a1 = cA + (size_t)(t + 1) * kstep;
            const char* a2 = last ? nA : cA + (size_t)(t + 2) * kstep; const char* b2 = last ? nB : cB + (size_t)(t + 2) * kstep;
            const char* a3 = a2 + kstep; const char* b3 = b2 + kstep;
            if (last && has_next) S.a_ready(nxt);
            if constexpr (SP2) {
            PG8_LDB(B0, 0, 0); PG8_LDB(B1, 0, 1); PG8_SCHED; PG8_LDA(At, 0, 0); PG8_STAGE(PG8_SA(1, 1), a1 + hstep, voffA);
            PG8_WAIT_V(8); PG8_WAIT_L(0); PG8_BAR; PG8_MMA(0, 0, At, B0); PG8_MMA(0, 1, At, B1); PG8_BAR; PG8_SCHED;
            PG8_LDA(At, 0, 1); PG8_STAGE(PG8_SB(0, 0), b2, voffB); PG8_STAGE(PG8_SB(0, 1), b2 + hstep, voffB); PG8_STAGE(PG8_SA(0, 0), a2, voffA);
            PG8_WAIT_V(8); PG8_WAIT_L(0); PG8_BAR; PG8_MMA(1, 0, At, B0); PG8_MMA(1, 1, At, B1); PG8_BAR; PG8_SCHED;
            PG8_LDB(B0, 1, 0); PG8_LDB(B1, 1, 1); PG8_SCHED; PG8_LDA(At, 1, 0); PG8_STAGE(PG8_SA(0, 1), a2 + hstep, voffA);
            PG8_WAIT_V(8); PG8_WAIT_L(0); PG8_BAR; PG8_MMA(0, 0, At, B0); PG8_MMA(0, 1, At, B1); PG8_BAR; PG8_SCHED;
            PG8_LDA(At, 1, 1); PG8_STAGE(PG8_SB(1, 0), b3, voffB); PG8_STAGE(PG8_SB(1, 1), b3 + hstep, voffB); PG8_STAGE(PG8_SA(1, 0), a3, voffA);
            PG8_WAIT_V(8); PG8_WAIT_L(0); PG8_BAR; PG8_MMA(1, 0, At, B0); PG8_MMA(1, 1, At, B1); PG8_BAR; PG8_SCHED;
            } else {
            PG8_LDB(B0, 0, 0); PG8_SCHED; PG8_LDA(At, 0, 0); PG8_STAGE(PG8_SA(1, 1), a1 + hstep, voffA);
            PG8_WAIT_L(8); PG8_BAR; PG8_WAIT_L(0); PG8_MMA(0, 0, At, B0); PG8_BAR; PG8_SCHED;
            PG8_LDB(B1, 0, 1); PG8_STAGE(PG8_SB(0, 0), b2, voffB);
            PG8_BAR; PG8_WAIT_L(0); PG8_MMA(0, 1, At, B1); PG8_BAR;
            PG8_LDA(At, 0, 1); PG8_STAGE(PG8_SA(0, 0), a2, voffA);
            PG8_BAR; PG8_WAIT_L(0); PG8_MMA(1, 0, At, B0); PG8_BAR; PG8_SCHED;
            PG8_STAGE(PG8_SB(0, 1), b2 + hstep, voffB);
            PG8_WAIT_V(6); PG8_BAR; PG8_MMA(1, 1, At, B1); PG8_BAR;
            PG8_LDB(B0, 1, 0); PG8_SCHED; PG8_LDA(At, 1, 0); PG8_STAGE(PG8_SA(0, 1), a2 + hstep, voffA);
            PG8_WAIT_L(8); PG8_BAR; PG8_WAIT_L(0); PG8_MMA(0, 0, At, B0); PG8_BAR; PG8_SCHED;
            PG8_LDB(B1, 1, 1); PG8_STAGE(PG8_SB(1, 0), b3, voffB);
            PG8_BAR; PG8_WAIT_L(0); PG8_MMA(0, 1, At, B1); PG8_BAR;
            PG8_LDA(At, 1, 1); PG8_STAGE(PG8_SA(1, 0), a3, voffA);
            PG8_BAR; PG8_WAIT_L(0); PG8_MMA(1, 0, At, B0); PG8_BAR; PG8_SCHED;
            PG8_STAGE(PG8_SB(1, 1), b3 + hstep, voffB);
            PG8_WAIT_V(6); PG8_BAR; PG8_MMA(1, 1, At, B1); PG8_BAR;
            }
        }
        if constexpr (ALIGN_EPI) { if (wr == 0) PG8_BAR; }
        if constexpr (!Epi::AFTER_DRAIN) { E(acc, cur, wr, wc, fr, fq); S.done(cur); }
        if (!has_next) break;
#pragma unroll
        for (int a = 0; a < 2; ++a)
#pragma unroll
            for (int b = 0; b < 2; ++b)
#pragma unroll
                for (int m = 0; m < 4; ++m)
#pragma unroll
                    for (int n = 0; n < 2; ++n) acc[a][b][m][n] = (f32x4){0.f, 0.f, 0.f, 0.f};
        cur = nxt; cA = nA; cB = nB; ++ui;
        if constexpr (ALIGN_EPI) { if (wr == 1) PG8_BAR; }
    }
    PG8_WAIT_V(0);
    if constexpr (!ALIGN_EPI) { if (wr == 0) PG8_BAR; }
    PG8_BAR;
    if constexpr (Epi::AFTER_DRAIN) { E.fused(acc, cur, wr, wc, fr, fq, lds, wid, lane); S.done(cur); }
#undef PG8_SA
#undef PG8_SB
#undef PG8_STAGE
#undef PG8_LDA
#undef PG8_LDB
#undef PG8_MMA
#undef PG8_WAIT_V
#undef PG8_WAIT_L
#undef PG8_BAR
#undef PG8_SCHED
}
}
using pg8::bf16_t; using pg8::bf16x8; using pg8::f32x4;
typedef float f32x16 __attribute__((ext_vector_type(16)));
typedef unsigned u32x4 __attribute__((ext_vector_type(4)));
typedef unsigned u32x2 __attribute__((ext_vector_type(2)));
typedef short s16x4 __attribute__((ext_vector_type(4)));
#define LAS __attribute__((address_space(3)))
constexpr int MP = 16384, MS = 128, MT = 16512, D = 1024, FF = 2816, NGU = 5632, NIN = 1280, NRKVL = 3328, NWAG = 3072;
constexpr int SEQ = 4096, NB_P = 4, NB_S = 8, LS = 16;
constexpr size_t MiB = 1u << 20;
constexpr size_t WE_GU0 = 0, WE_DN0 = WE_GU0 + (size_t)NGU * D, WE_GU1 = WE_DN0 + (size_t)D * FF, WE_DN1 = WE_GU1 + (size_t)NGU * D, WE_MIX = WE_DN1 + (size_t)D * FF;
constexpr size_t WE_IN = WE_MIX, WE_OUT = WE_IN + (size_t)NIN * D;
constexpr size_t WE_RKVL = WE_MIX, WE_WAG = WE_RKVL + (size_t)NRKVL * 2048, WE_WO = WE_WAG + (size_t)NWAG * 256, WE_END = WE_WO + (size_t)D * D;
static_assert(WE_END * 2 <= 50 * MiB, "weights region");
constexpr size_t WS_W = 0, WS_XB = 50 * MiB, WS_WEFF = 82 * MiB, WS_SS = 86 * MiB, WS_A0 = 88 * MiB, WS_B2 = 177 * MiB, WS_B3 = 285 * MiB, WS_END = 384 * MiB;
constexpr size_t WS_Z = WS_A0, WS_CAT = WS_A0 + 41 * MiB, WS_HH = WS_A0, WS_LD = WS_A0;
constexpr size_t WS_R = WS_B2, WS_K = WS_B2 + 33 * MiB, WS_V = WS_B2 + 66 * MiB, WS_LORA = WS_B2 + 99 * MiB;
constexpr size_t WS_AA = WS_B3, WS_G = WS_B3 + 33 * MiB, WS_AWO = WS_B3 + 66 * MiB;
static_assert((size_t)MT * FF * 2 <= 89 * MiB && (size_t)MT * NIN * 2 <= 41 * MiB && (size_t)MT * D * 2 <= 33 * MiB && (size_t)MT * 256 * 2 <= 9 * MiB && (size_t)MT * D * 4 <= 89 * MiB, "arena");
constexpr size_t O_Y = 0, O_POOLP = 16908288, O_POOLS = 16969728, O_KP = 17092608, O_KS = 17223680, O_VP = 17485824, O_VS = 17616896, O_SHP = 17879040, O_SHS = 17887232, O_WKVP = 17903616, O_WKVS = 18427904, O_END = 19476480;
constexpr int LDS_BYTES = 131072 + 1024;

struct Args { const float* in[37]; float* out; unsigned char* ws; int ph_lo, ph_hi; };
typedef const __attribute__((address_space(4))) Args* ArgsP;

__device__ __forceinline__ unsigned pk2(float lo, float hi) { typedef float f2 __attribute__((ext_vector_type(2))); typedef __bf16 b2 __attribute__((ext_vector_type(2))); f2 v = {lo, hi}; b2 b = __builtin_convertvector(v, b2); return __builtin_bit_cast(unsigned, b); }
__device__ __forceinline__ int mk_tid(int wave_s) { unsigned ones = ~0u; asm volatile("" : "+s"(ones)); const int lane = __builtin_amdgcn_mbcnt_hi(ones, __builtin_amdgcn_mbcnt_lo(ones, 0u)); return wave_s * 64 + lane; }
__device__ __forceinline__ float bflo(unsigned u) { return __builtin_bit_cast(float, u << 16); }
__device__ __forceinline__ float bfhi(unsigned u) { return __builtin_bit_cast(float, u & 0xffff0000u); }
__device__ __forceinline__ float sigmoidf_(float x) { return 1.f / (1.f + __expf(-x)); }
__device__ __forceinline__ float wave_sum(float v) {
#pragma unroll
    for (int o = 1; o < 64; o <<= 1) v += __shfl_xor(v, o);
    return v;
}
template <int CTRL> __device__ __forceinline__ float dpp_f(float v) { return __builtin_bit_cast(float, __builtin_amdgcn_update_dpp(0, __builtin_bit_cast(int, v), CTRL, 0xF, 0xF, true)); }
__device__ __forceinline__ float red8(float v) { v += dpp_f<0xB1>(v); v += dpp_f<0x4E>(v); v += dpp_f<0x141>(v); return v; }
__device__ __forceinline__ float red16(float v) { v = red8(v); v += dpp_f<0x140>(v); return v; }
__device__ __forceinline__ float ss_rstd(const float* ssrow) { const f32x4 a = *(const f32x4*)ssrow, b = *(const f32x4*)(ssrow + 4), c = *(const f32x4*)(ssrow + 8), d = *(const f32x4*)(ssrow + 12);
    const float s = ((a[0] + a[1]) + (a[2] + a[3])) + ((b[0] + b[1]) + (b[2] + b[3])) + ((c[0] + c[1]) + (c[2] + c[3])) + ((d[0] + d[1]) + (d[2] + d[3])); return rsqrtf(s * (1.f / D) + 1e-6f); }
__device__ __forceinline__ u32x4 pack8(const f32x4& a, const f32x4& b) { u32x4 w; w.x = pk2(a[0], a[1]); w.y = pk2(a[2], a[3]); w.z = pk2(b[0], b[1]); w.w = pk2(b[2], b[3]); return w; }
__device__ __forceinline__ u32x2 pack4(const f32x4& a) { u32x2 w; w.x = pk2(a[0], a[1]); w.y = pk2(a[2], a[3]); return w; }

#define EPI_LOOP_ROWS for (int am_ = 0; am_ < 8; ++am_)
#define EPI_AM const int ai = am_ >> 2, m = am_ & 3;
struct EpiSwiglu {
    static constexpr bool PERM = true, AFTER_DRAIN = false;
    const float* ss; bf16_t* act;
    __device__ __forceinline__ void operator()(const f32x4 (&acc)[2][2][4][2], const pg8::Unit& u, int wr, int wc, int fr, int fq) const { asm volatile("" : "+v"(fr), "+v"(fq));
#pragma unroll
        EPI_LOOP_ROWS { EPI_AM const int row = u.pm * 256 + ai * 128 + wr * 64 + m * 16 + fr; const float rstd = ss_rstd(ss + (size_t)row * 16);
#pragma unroll
            for (int bj = 0; bj < 2; ++bj) { const int col0 = u.pn * 256 + bj * 128 + wc * 32 + 8 * fq; const f32x4 g = acc[ai][bj][m][0] * rstd, up = acc[ai][bj][m][1] * rstd; f32x4 o;
#pragma unroll
                for (int j = 0; j < 4; ++j) o[j] = g[j] * sigmoidf_(g[j]) * up[j];
                *(u32x2*)(act + (size_t)row * FF + (col0 >> 1)) = pack4(o); } }
    }
};
struct EpiResid {
    static constexpr bool PERM = true, AFTER_DRAIN = false;
    float* x; bf16_t* xb; float* ssn; float scale;
    __device__ __forceinline__ void operator()(const f32x4 (&acc)[2][2][4][2], const pg8::Unit& u, int wr, int wc, int fr, int fq) const { asm volatile("" : "+v"(fr), "+v"(fq));
#pragma unroll
        EPI_LOOP_ROWS { EPI_AM const int row = u.pm * 256 + ai * 128 + wr * 64 + m * 16 + fr; float sq = 0.f;
#pragma unroll
            for (int bj = 0; bj < 2; ++bj) { const int col0 = u.pn * 256 + bj * 128 + wc * 32 + 8 * fq; float* xp = x + (size_t)row * D + col0;
                f32x4 x0 = *(const f32x4*)xp, x1 = *(const f32x4*)(xp + 4); x0 += acc[ai][bj][m][0] * scale; x1 += acc[ai][bj][m][1] * scale;
                *(f32x4*)xp = x0; *(f32x4*)(xp + 4) = x1; *(u32x4*)(xb + (size_t)row * D + col0) = pack8(x0, x1);
                sq += (x0[0] * x0[0] + x0[1] * x0[1]) + (x0[2] * x0[2] + x0[3] * x0[3]) + (x1[0] * x1[0] + x1[1] * x1[1]) + (x1[2] * x1[2] + x1[3] * x1[3]); }
            sq += __shfl_xor(sq, 16); sq += __shfl_xor(sq, 32);
            if (fq == 0) ssn[(size_t)row * 16 + u.pn * 4 + wc] = sq; }
    }
};
struct EpiZ {
    static constexpr bool PERM = true, AFTER_DRAIN = false;
    const float* ss; bf16_t* z;
    __device__ __forceinline__ void operator()(const f32x4 (&acc)[2][2][4][2], const pg8::Unit& u, int wr, int wc, int fr, int fq) const { asm volatile("" : "+v"(fr), "+v"(fq));
#pragma unroll
        EPI_LOOP_ROWS { EPI_AM const int row = u.pm * 256 + ai * 128 + wr * 64 + m * 16 + fr; const float rstd = ss_rstd(ss + (size_t)row * 16);
#pragma unroll
            for (int bj = 0; bj < 2; ++bj) { const int col0 = u.pn * 256 + bj * 128 + wc * 32 + 8 * fq;
                *(u32x4*)(z + (size_t)row * NIN + col0) = pack8(acc[ai][bj][m][0] * rstd, acc[ai][bj][m][1] * rstd); } }
    }
};
__device__ __forceinline__ float lora_act(float v, int c) { return c < 64 ? (1.f - 2.f / (__expf(2.f * v) + 1.f)) : (c < 128 ? v : sigmoidf_(v)); }
struct EpiRkvl {
    static constexpr bool PERM = true, AFTER_DRAIN = false;
    bf16_t* rkv; size_t stride; bf16_t* lora;
    __device__ __forceinline__ void operator()(const f32x4 (&acc)[2][2][4][2], const pg8::Unit& u, int wr, int wc, int fr, int fq) const { asm volatile("" : "+v"(fr), "+v"(fq));
        const int t = u.pn >> 2; const int rb = u.pm * 256 + wr * 64 + fr, cb = wc * 32 + 8 * fq;
        if (t < 3) { bf16_t* base = rkv + t * stride + (size_t)rb * D + (u.pn & 3) * 256 + cb;
#pragma unroll
            for (int am_ = 0; am_ < 8; ++am_) { const int ai = am_ >> 2, m = am_ & 3;
#pragma unroll
                for (int bj = 0; bj < 2; ++bj) *(u32x4*)(base + (size_t)(ai * 128 + m * 16) * D + bj * 128) = pack8(acc[ai][bj][m][0], acc[ai][bj][m][1]); }
        } else { bf16_t* base = lora + (size_t)rb * 256 + cb;
#pragma unroll
            for (int am_ = 0; am_ < 8; ++am_) { const int ai = am_ >> 2, m = am_ & 3;
#pragma unroll
                for (int bj = 0; bj < 2; ++bj) { f32x4 a = acc[ai][bj][m][0], b = acc[ai][bj][m][1]; const int cl = bj * 128 + cb;
#pragma unroll
                    for (int j = 0; j < 4; ++j) { a[j] = lora_act(a[j], cl); b[j] = lora_act(b[j], cl); }
                    *(u32x4*)(base + (size_t)(ai * 128 + m * 16) * 256 + bj * 128) = pack8(a, b); } }
        }
    }
};
__device__ __forceinline__ float wag_w(float v) { const float y = -v; const float sp = fmaxf(y, 0.f) + __logf(1.f + __expf(-fabsf(y))); return -__expf(-sp - 0.5f); }
struct EpiWag {
    static constexpr bool PERM = true, AFTER_DRAIN = false;
    const float* w0; const float* a0; float* ld; bf16_t* aa; bf16_t* gg;
    __device__ __forceinline__ void operator()(const f32x4 (&acc)[2][2][4][2], const pg8::Unit& u, int wr, int wc, int fr, int fq) const { asm volatile("" : "+v"(fr), "+v"(fq));
        const int t = u.pn >> 2; const int cb = (u.pn & 3) * 256 + wc * 32 + 8 * fq; const int rb = u.pm * 256 + wr * 64 + fr;
        if (t == 0) {
#pragma unroll
            for (int bj = 0; bj < 2; ++bj) { const int c = cb + bj * 128; const f32x4 b0 = *(const f32x4*)(w0 + c), b1 = *(const f32x4*)(w0 + c + 4);
#pragma unroll
                for (int am_ = 0; am_ < 8; ++am_) { const int ai = am_ >> 2, m = am_ & 3; const int row = rb + ai * 128 + m * 16; f32x4 a = acc[ai][bj][m][0], b = acc[ai][bj][m][1];
#pragma unroll
                    for (int j = 0; j < 4; ++j) { a[j] = wag_w(a[j] + b0[j]); b[j] = wag_w(b[j] + b1[j]); }
                    *(f32x4*)(ld + (size_t)row * D + c) = a; *(f32x4*)(ld + (size_t)row * D + c + 4) = b; } }
        } else if (t == 1) {
#pragma unroll
            for (int bj = 0; bj < 2; ++bj) { const int c = cb + bj * 128; const f32x4 b0 = *(const f32x4*)(a0 + c), b1 = *(const f32x4*)(a0 + c + 4);
#pragma unroll
                for (int am_ = 0; am_ < 8; ++am_) { const int ai = am_ >> 2, m = am_ & 3; const int row = rb + ai * 128 + m * 16; f32x4 a = acc[ai][bj][m][0], b = acc[ai][bj][m][1];
#pragma unroll
                    for (int j = 0; j < 4; ++j) { a[j] = sigmoidf_(a[j] + b0[j]); b[j] = sigmoidf_(b[j] + b1[j]); }
                    *(u32x4*)(aa + (size_t)row * D + c) = pack8(a, b); } }
        } else {
#pragma unroll
            for (int bj = 0; bj < 2; ++bj) { const int c = cb + bj * 128;
#pragma unroll
                for (int am_ = 0; am_ < 8; ++am_) { const int ai = am_ >> 2, m = am_ & 3; const int row = rb + ai * 128 + m * 16;
                    *(u32x4*)(gg + (size_t)row * D + c) = pack8(acc[ai][bj][m][0], acc[ai][bj][m][1]); } }
        }
    }
};
#define MFMA16(a, b, c) __builtin_amdgcn_mfma_f32_16x16x32_bf16((a), (b), (c), 0, 0, 0)
struct ALbf16 { const bf16_t* A; int lda;
    __device__ __forceinline__ bf16x8 load(int row, int k, float& sq) const { return *(const bf16x8*)(A + (size_t)row * lda + k); } };
struct ALx { const float* x;
    __device__ __forceinline__ bf16x8 load(int row, int k, float& sq) const { const f32x4 a = *(const f32x4*)(x + (size_t)row * D + k), b = *(const f32x4*)(x + (size_t)row * D + k + 4);
        sq += (a[0] * a[0] + a[1] * a[1]) + (a[2] * a[2] + a[3] * a[3]) + (b[0] * b[0] + b[1] * b[1]) + (b[2] * b[2] + b[3] * b[3]); return __builtin_bit_cast(bf16x8, pack8(a, b)); } };
template <int NB, class AL, class EP>
__device__ __forceinline__ void sgemm(int tid, int ntile, int ksplit, int Kc, const bf16_t* Bt, int ldb, const AL al, const EP ep) {
    const int lane = tid & 63, w = tid >> 6, fr = lane & 15, fq = lane >> 4, row = 16 * w + fr;
    for (int t = blockIdx.x; t < ntile * ksplit; t += gridDim.x) {
        const int tn = t % ntile, ks = t / ntile, kb = ks * Kc + 8 * fq;
        f32x4 acc[NB]; const bf16_t* bp[NB];
#pragma unroll
        for (int nb = 0; nb < NB; ++nb) { acc[nb] = (f32x4){0.f, 0.f, 0.f, 0.f}; bp[nb] = Bt + (size_t)ep.brow(tn, nb, fr) * ldb + kb; }
        float sq = 0.f;
#pragma unroll 4
        for (int k = 0; k < Kc; k += 32) { const bf16x8 a = al.load(row, kb + k, sq);
#pragma unroll
            for (int nb = 0; nb < NB; ++nb) { const bf16x8 b = *(const bf16x8*)(bp[nb] + k); acc[nb] = MFMA16(b, a, acc[nb]); } }
        sq += __shfl_xor(sq, 16); sq += __shfl_xor(sq, 32);
        ep(tn, row, fq, acc, sq);
    }
}
struct SEpiSwiglu { bf16_t* act;
    __device__ __forceinline__ int brow(int tn, int nb, int i) const { const int a = 16 * tn + i; return 8 * (a >> 2) + 4 * nb + (a & 3); }
    __device__ __forceinline__ void operator()(int tn, int row, int fq, const f32x4 (&acc)[2], float sq) const { const float rstd = rsqrtf(sq * (1.f / D) + 1e-6f); f32x4 o;
#pragma unroll
        for (int j = 0; j < 4; ++j) { const float g = acc[0][j] * rstd; o[j] = g * sigmoidf_(g) * (acc[1][j] * rstd); }
        *(u32x2*)(act + (size_t)row * FF + 16 * tn + 4 * fq) = pack4(o); } };
__device__ __forceinline__ void sgemm_resid(int tid, LAS unsigned char* lds, const bf16_t* A, const bf16_t* Bt, int K, float* x, float scale) {
    const int lane = tid & 63, w = tid >> 6, fr = lane & 15, fq = lane >> 4, Kc = K >> 3, kb = w * Kc + 8 * fq;
    LAS f32x4* part = (LAS f32x4*)lds;
    for (int t = blockIdx.x; t < 32; t += gridDim.x) {
        f32x4 acc[8][2];
#pragma unroll
        for (int rb = 0; rb < 8; ++rb) { acc[rb][0] = (f32x4){0.f, 0.f, 0.f, 0.f}; acc[rb][1] = (f32x4){0.f, 0.f, 0.f, 0.f}; }
        const bf16_t* bp0 = Bt + (size_t)(32 * t + fr) * K + kb; const bf16_t* bp1 = bp0 + (size_t)16 * K; const bf16_t* ap = A + (size_t)fr * K + kb;
        for (int k = 0; k < Kc; k += 32) { const bf16x8 b0 = *(const bf16x8*)(bp0 + k), b1 = *(const bf16x8*)(bp1 + k);
#pragma unroll
            for (int rb = 0; rb < 8; ++rb) { const bf16x8 av = *(const bf16x8*)(ap + (size_t)(16 * rb) * K + k); acc[rb][0] = MFMA16(b0, av, acc[rb][0]); acc[rb][1] = MFMA16(b1, av, acc[rb][1]); } }
#pragma unroll
        for (int rb = 0; rb < 8; ++rb) { part[(w * 16 + rb * 2) * 64 + lane] = acc[rb][0]; part[(w * 16 + rb * 2 + 1) * 64 + lane] = acc[rb][1]; }
        __syncthreads();
#pragma unroll
        for (int nb = 0; nb < 2; ++nb) { f32x4 s = part[(w * 2 + nb) * 64 + lane];
#pragma unroll
            for (int ww = 1; ww < 8; ++ww) s += part[(ww * 16 + w * 2 + nb) * 64 + lane];
            float* xp = x + (size_t)(16 * w + fr) * D + 32 * t + 16 * nb + 4 * fq; f32x4 xv = *(const f32x4*)xp; xv += s * scale; *(f32x4*)xp = xv; }
        __syncthreads();
    }
}
struct SEpiZ { bf16_t* z;
    __device__ __forceinline__ int brow(int tn, int nb, int i) const { return 32 * tn + 16 * nb + i; }
    __device__ __forceinline__ void operator()(int tn, int row, int fq, const f32x4 (&acc)[2], float sq) const { const float rstd = rsqrtf(sq * (1.f / D) + 1e-6f);
#pragma unroll
        for (int nb = 0; nb < 2; ++nb) *(u32x2*)(z + (size_t)row * NIN + 32 * tn + 16 * nb + 4 * fq) = pack4(acc[nb] * rstd); } };
struct SEpiRkvl { bf16_t* rkv; size_t stride; bf16_t* lora;
    __device__ __forceinline__ int brow(int tn, int nb, int i) const { return 32 * tn + 16 * nb + i; }
    __device__ __forceinline__ void operator()(int tn, int row, int fq, const f32x4 (&acc)[2], float sq) const {
#pragma unroll
        for (int nb = 0; nb < 2; ++nb) { const int c = 32 * tn + 16 * nb + 4 * fq;
            if (c < 3072) *(u32x2*)(rkv + (size_t)(c >> 10) * stride + (size_t)row * D + (c & 1023)) = pack4(acc[nb]);
            else { f32x4 a = acc[nb]; const int cl = c - 3072;
#pragma unroll
                for (int j = 0; j < 4; ++j) a[j] = lora_act(a[j], cl);
                *(u32x2*)(lora + (size_t)row * 256 + cl) = pack4(a); } } } };
struct SEpiWag { const float* w0; const float* a0; float* ld; bf16_t* aa; bf16_t* gg;
    __device__ __forceinline__ int brow(int tn, int nb, int i) const { return 32 * tn + 16 * nb + i; }
    __device__ __forceinline__ void operator()(int tn, int row, int fq, const f32x4 (&acc)[2], float sq) const {
#pragma unroll
        for (int nb = 0; nb < 2; ++nb) { const int cc = 32 * tn + 16 * nb + 4 * fq, t = cc >> 10, c = cc & 1023; f32x4 a = acc[nb];
            if (t == 0) { const f32x4 b0 = *(const f32x4*)(w0 + c);
#pragma unroll
                for (int j = 0; j < 4; ++j) a[j] = wag_w(a[j] + b0[j]);
                *(f32x4*)(ld + (size_t)row * D + c) = a; }
            else if (t == 1) { const f32x4 b0 = *(const f32x4*)(a0 + c);
#pragma unroll
                for (int j = 0; j < 4; ++j) a[j] = sigmoidf_(a[j] + b0[j]);
                *(u32x2*)(aa + (size_t)row * D + c) = pack4(a); }
            else *(u32x2*)(gg + (size_t)row * D + c) = pack4(a); } } };
struct TrSpec { const float* W; int K, N; const float* ks; int ksmode; bf16_t* WT; int ldT, kofs, rowmode, rowoff; };
__device__ __forceinline__ TrSpec make_spec(ArgsP a, int l, int si) {
    TrSpec s; const int i = l >> 1; bf16_t* W = (bf16_t*)(a->ws + WS_W);
    s.ks = nullptr; s.ksmode = 0; s.kofs = 0; s.rowmode = 0; s.rowoff = 0;
    if (si < 6) { const int j = si / 3, t = si % 3; const size_t lj = (size_t)(l * 2 + j);
        if (t < 2) { s.W = (t == 0 ? a->in[9] : a->in[10]) + lj * D * FF; s.K = D; s.N = FF; s.ks = a->in[8] + lj * D; s.ksmode = 1; s.WT = W + (j ? WE_GU1 : WE_GU0); s.ldT = D; s.rowmode = 1 + t; }
        else { s.W = a->in[11] + lj * FF * D; s.K = FF; s.N = D; s.WT = W + (j ? WE_DN1 : WE_DN0); s.ldT = FF; }
        return s; }
    if ((l & 1) == 0) {
        if (si == 6) { s.W = a->in[13] + (size_t)i * D * NIN; s.K = D; s.N = NIN; s.ks = a->in[12] + l * D; s.ksmode = 1; s.WT = W + WE_IN; s.ldT = D; }
        else if (si == 7) { s.W = a->in[17] + (size_t)i * D * D + 512 * D; s.K = 512; s.N = D; s.WT = W + WE_OUT; s.ldT = D; s.kofs = 512; }
        else { s.W = (const float*)(a->ws + WS_WEFF) + (size_t)i * 512 * D; s.K = 512; s.N = D; s.WT = W + WE_OUT; s.ldT = D; }
    } else {
        if (si == 18) { s.W = a->in[35] + (size_t)i * D * D; s.K = D; s.N = D; s.WT = W + WE_WO; s.ldT = D; }
        else { const int q = (si - 6) >> 1, hi = (si - 6) & 1;
            const int n = q < 3 ? 1024 : (q < 5 ? 64 : 128);
            const float* src = q == 0 ? a->in[19] : q == 1 ? a->in[20] : q == 2 ? a->in[21] : q == 3 ? a->in[23] : q == 4 ? a->in[26] : a->in[28];
            const int mui = q == 0 ? 0 : q == 1 ? 2 : q == 2 ? 3 : q == 3 ? 1 : q == 4 ? 4 : 5;
            s.W = src + (size_t)i * D * n; s.K = D; s.N = n; s.ks = a->in[18] + (size_t)(i * 6 + mui) * D; s.ksmode = hi ? 1 : 2; s.WT = W + WE_RKVL; s.ldT = 2048; s.kofs = hi ? 1024 : 0;
            s.rowoff = q < 3 ? 1024 * q : (q == 3 ? 3072 : (q == 4 ? 3136 : 3200)); }
    }
    return s;
}
__device__ __forceinline__ void tr_item(const TrSpec& s, LAS float* scr, int item, int lane) {
    const int nblk = s.N / 32, kb = item / nblk, nb = item % nblk, k0 = 64 * kb, n0 = 32 * nb;
#pragma unroll 8
    for (int i = 0; i < 32; ++i) { const int kk = 2 * i + (lane >> 5); float v = s.W[(size_t)(k0 + kk) * s.N + n0 + (lane & 31)];
        if (s.ksmode) { const float m = s.ks[k0 + kk]; v *= (s.ksmode == 1 ? m : 1.f - m); }
        scr[kk * 33 + (lane & 31)] = v; }
    asm volatile("s_waitcnt lgkmcnt(0)" ::: "memory");
    const int c = lane & 7;
#pragma unroll
    for (int j = 0; j < 4; ++j) { const int n = (lane >> 3) + 8 * j; const LAS float* p = scr + (8 * c) * 33 + n; const int gn = n0 + n;
        const int drow = s.rowmode == 0 ? s.rowoff + gn : (8 * (gn >> 2) + (gn & 3) + (s.rowmode == 2 ? 4 : 0));
        u32x4 o; o.x = pk2(p[0 * 33], p[1 * 33]); o.y = pk2(p[2 * 33], p[3 * 33]); o.z = pk2(p[4 * 33], p[5 * 33]); o.w = pk2(p[6 * 33], p[7 * 33]);
        *(u32x4*)(s.WT + (size_t)drow * s.ldT + s.kofs + k0 + 8 * c) = o; }
    asm volatile("s_waitcnt lgkmcnt(0)" ::: "memory");
}
__device__ __forceinline__ void convert_layer(ArgsP a, int l, LAS unsigned char* lds, const int tid) {
    const int lane = tid & 63, wave = tid >> 6, gw = blockIdx.x * 8 + wave, NGW = gridDim.x * 8;
    LAS float* scr = (LAS float*)(lds + wave * 16384);
    const int nspec = (l & 1) ? 19 : 9;
    int base = 0;
    for (int si = 0; si < nspec; ++si) { const TrSpec s = make_spec(a, l, si); const int items = (s.K / 64) * (s.N / 32);
        int first = gw - (base % NGW); if (first < 0) first += NGW;
        for (int it = first; it < items; it += NGW) tr_item(s, scr, it, lane);
        base += items; }
    if (l & 1) { const int i = l >> 1; bf16_t* WT = (bf16_t*)(a->ws + WS_W) + WE_WAG;
        for (int q = blockIdx.x * 512 + tid; q < NWAG * 32; q += gridDim.x * 512) { const int n = q % NWAG, k0 = (q / NWAG) * 8, t = n >> 10, c = n & 1023;
            const float* src = nullptr; int kb = 0;
            if (t == 0 && k0 < 64) { src = a->in[24] + (size_t)i * 64 * D; kb = k0; } else if (t == 1 && k0 >= 64 && k0 < 128) { src = a->in[27] + (size_t)i * 64 * D; kb = k0 - 64; } else if (t == 2 && k0 >= 128) { src = a->in[29] + (size_t)i * 128 * D; kb = k0 - 128; }
            u32x4 o = {0u, 0u, 0u, 0u};
            if (src) { float v[8];
#pragma unroll
                for (int e = 0; e < 8; ++e) v[e] = src[(size_t)(kb + e) * D + c];
                o.x = pk2(v[0], v[1]); o.y = pk2(v[2], v[3]); o.z = pk2(v[4], v[5]); o.w = pk2(v[6], v[7]); }
            *(u32x4*)(WT + (size_t)n * 256 + k0) = o; } }
}
__device__ __forceinline__ void phase_init(ArgsP a, const int tid) {
    const int lane = tid & 63, gw = blockIdx.x * 8 + (tid >> 6), NGW = gridDim.x * 8;
    float* x = a->out; bf16_t* xb = (bf16_t*)(a->ws + WS_XB); float* ss = (float*)(a->ws + WS_SS);
    for (int m = gw; m < MT; m += NGW) { const float* src = m < MP ? a->in[0] + (size_t)m * D : a->in[1] + (size_t)(m - MP) * D; float s = 0.f; f32x4 v[4];
#pragma unroll
        for (int j = 0; j < 4; ++j) { v[j] = *(const f32x4*)(src + 4 * lane + 256 * j); *(f32x4*)(x + (size_t)m * D + 4 * lane + 256 * j) = v[j]; s += (v[j][0] * v[j][0] + v[j][1] * v[j][1]) + (v[j][2] * v[j][2] + v[j][3] * v[j][3]); }
        if (m < MP) { s = wave_sum(s); if (lane < 16) ss[(size_t)m * 16 + lane] = lane == 0 ? s : 0.f;
#pragma unroll
            for (int j = 0; j < 4; ++j) *(u32x2*)(xb + (size_t)m * D + 4 * lane + 256 * j) = pack4(v[j]); } }
    const int gt = blockIdx.x * 512 + tid, NT = gridDim.x * 512;
    float* weff = (float*)(a->ws + WS_WEFF);
    for (int q = gt; q < 2 * 512 * D; q += NT) { const int i = q >> 19, k = (q >> 10) & 511, n = q & 1023, g = k >> 7;
        const float* pw = a->in[14] + ((size_t)(i * 4 + g) * 128 + (k & 127)) * 128; const float* ps = a->in[15] + i * 512 + g * 128; const float* wo = a->in[17] + (size_t)i * D * D + (size_t)(g * 128) * D + n;
        float acc = 0.f;
        for (int d = 0; d < 128; ++d) acc += pw[d] * ps[d] * wo[(size_t)d * D];
        weff[q] = acc; }
}
__device__ __forceinline__ void phase_final(ArgsP a, const int tid) {
    const int lane = tid & 63, gw = blockIdx.x * 8 + (tid >> 6), NGW = gridDim.x * 8; float* x = a->out; const float* gn = a->in[36];
    for (int m = gw; m < MT; m += NGW) { float s = 0.f; f32x4 v[4];
#pragma unroll
        for (int j = 0; j < 4; ++j) { v[j] = *(const f32x4*)(x + (size_t)m * D + 4 * lane + 256 * j); s += (v[j][0] * v[j][0] + v[j][1] * v[j][1]) + (v[j][2] * v[j][2] + v[j][3] * v[j][3]); }
        const float rstd = rsqrtf(wave_sum(s) * (1.f / D) + 1e-6f);
#pragma unroll
        for (int j = 0; j < 4; ++j) { const f32x4 g = *(const f32x4*)(gn + 4 * lane + 256 * j); *(f32x4*)(x + (size_t)m * D + 4 * lane + 256 * j) = v[j] * rstd * g; } }
}
__device__ __forceinline__ void phase_shift(ArgsP a, int l, const int tid) {
    const int i = l >> 1, lane = tid & 63, gw = blockIdx.x * 8 + (tid >> 6), NGW = gridDim.x * 8;
    const float* x = a->out; const float* gn = a->in[12] + l * D; bf16_t* hh = (bf16_t*)(a->ws + WS_HH);
    for (int m = gw; m < MT; m += NGW) { int b, t; const bool smp = m >= MP; if (!smp) { b = m >> 12; t = m & 4095; } else { b = (m - MP) >> 4; t = (m - MP) & 15; }
        f32x4 v[4], p[4]; float s = 0.f, sp = 0.f;
#pragma unroll
        for (int j = 0; j < 4; ++j) { v[j] = *(const f32x4*)(x + (size_t)m * D + 4 * lane + 256 * j); s += (v[j][0] * v[j][0] + v[j][1] * v[j][1]) + (v[j][2] * v[j][2] + v[j][3] * v[j][3]); }
        if (t > 0) {
#pragma unroll
            for (int j = 0; j < 4; ++j) { p[j] = *(const f32x4*)(x + (size_t)(m - 1) * D + 4 * lane + 256 * j); sp += (p[j][0] * p[j][0] + p[j][1] * p[j][1]) + (p[j][2] * p[j][2] + p[j][3] * p[j][3]); } }
        const float rstd = rsqrtf(wave_sum(s) * (1.f / D) + 1e-6f), rstdp = rsqrtf(wave_sum(sp) * (1.f / D) + 1e-6f);
#pragma unroll
        for (int j = 0; j < 4; ++j) { const int c = 4 * lane + 256 * j; const f32x4 g = *(const f32x4*)(gn + c); const f32x4 h = v[j] * rstd * g; f32x4 hp;
            if (t > 0) hp = p[j] * rstdp * g; else if (smp) hp = *(const f32x4*)(a->in[5] + (size_t)(i * NB_S + b) * D + c); else hp = (f32x4){0.f, 0.f, 0.f, 0.f};
            *(u32x2*)(hh + (size_t)m * 2048 + c) = pack4(h); *(u32x2*)(hh + (size_t)m * 2048 + 1024 + c) = pack4(hp);
            if (!smp && t == SEQ - 1) *(f32x4*)(a->out + O_SHP + (size_t)(i * NB_P + b) * D + c) = h;
            if (smp && t == LS - 1) *(f32x4*)(a->out + O_SHS + (size_t)(i * NB_S + b) * D + c) = h; } }
}
#define MFMA32(a, b, c) __builtin_amdgcn_mfma_f32_32x32x16_bf16((a), (b), (c), 0, 0, 0)
__device__ __forceinline__ int t5_bucket(int rel) { const int n = rel < 0 ? -rel : rel; const int side = rel > 0 ? 16 : 0;
    const int b = n < 8 ? n : n < 12 ? 8 : n < 16 ? 9 : n < 23 ? 10 : n < 32 ? 11 : n < 46 ? 12 : n < 64 ? 13 : n < 91 ? 14 : 15; return side + b; }
__device__ __forceinline__ void phase_attn(ArgsP a, int i, LAS unsigned char* lds, const int tid) {
    const bf16_t* z = (const bf16_t*)(a->ws + WS_Z); bf16_t* cat = (bf16_t*)(a->ws + WS_CAT);
    LAS bf16_t* Kl = (LAS bf16_t*)lds;
    LAS bf16_t* Vt = (LAS bf16_t*)(lds + 27648);
    LAS float* bl = (LAS float*)(lds + 27648 + 25600);
    const int lane = tid & 63, w = tid >> 6, r = lane & 31, h = lane >> 5;
    const float* t5 = a->in[7];
    for (int u = blockIdx.x; u < 512 + 16; u += gridDim.x) {
        const bool smp = u >= 512; int b, c, hk;
        if (!smp) { hk = u & 1; c = (u >> 1) & 63; b = u >> 7; } else { hk = (u - 512) & 1; b = (u - 512) >> 1; c = 2; }
        for (int q = tid; q < 192 * 8; q += 512) { const int j = q >> 3, ch = q & 7; u32x4 kv = {0u, 0u, 0u, 0u}, vv = {0u, 0u, 0u, 0u};
            if (!smp) { const int t = 64 * (c - 2) + j; if (t >= 0) { const bf16_t* p = z + (size_t)(b * SEQ + t) * NIN + 1024 + hk * 64 + ch * 8; kv = *(const u32x4*)p; vv = *(const u32x4*)(p + 128); } }
            else if (j < 128) { const size_t o = ((size_t)((i * NB_S + b) * 128 + j) * 2 + hk) * 64 + ch * 8;
                kv = pack8(*(const f32x4*)(a->in[3] + o), *(const f32x4*)(a->in[3] + o + 4)); vv = pack8(*(const f32x4*)(a->in[4] + o), *(const f32x4*)(a->in[4] + o + 4)); }
            else if (j < 144) { const bf16_t* p = z + (size_t)(MP + b * LS + (j - 128)) * NIN + 1024 + hk * 64 + ch * 8; kv = *(const u32x4*)p; vv = *(const u32x4*)(p + 128); }
            *(LAS u32x4*)(Kl + j * 72 + ch * 8) = kv;
            LAS bf16_t* vp = Vt + (ch * 8) * 200 + j;
            vp[0] = (bf16_t)(vv.x & 0xffffu); vp[200] = (bf16_t)(vv.x >> 16); vp[400] = (bf16_t)(vv.y & 0xffffu); vp[600] = (bf16_t)(vv.y >> 16);
            vp[800] = (bf16_t)(vv.z & 0xffffu); vp[1000] = (bf16_t)(vv.z >> 16); vp[1200] = (bf16_t)(vv.w & 0xffffu); vp[1400] = (bf16_t)(vv.w >> 16); }
        for (int q = tid; q < 1024; q += 512) { const int g = q >> 8, ri = q & 255; bl[q] = ri < 255 ? t5[t5_bucket(ri - 191) * 8 + hk * 4 + g] : 0.f; }
        __syncthreads();
        if (!smp || w < 2) {
            int g, iq, qrow; if (!smp) { g = w >> 1; iq = 32 * (w & 1) + r; qrow = b * SEQ + 64 * c + iq; } else { g = 2 * w + (r >> 4); iq = r & 15; qrow = MP + b * LS + iq; }
            const int head = hk * 4 + g; const float sink = a->in[16][i * 8 + head];
            bf16x8 qf[4];
#pragma unroll
            for (int s = 0; s < 4; ++s) qf[s] = *(const bf16x8*)(z + (size_t)qrow * NIN + 512 + head * 64 + 16 * s + 8 * h);
            f32x16 st[6];
#pragma unroll
            for (int kb = 0; kb < 6; ++kb) {
#pragma unroll
                for (int e = 0; e < 16; ++e) st[kb][e] = 0.f;
#pragma unroll
                for (int s = 0; s < 4; ++s) { const bf16x8 kf = *(const LAS bf16x8*)(Kl + (32 * kb + r) * 72 + 16 * s + 8 * h); st[kb] = MFMA32(kf, qf[s], st[kb]); } }
            const int kmin = smp ? 0 : (c >= 2 ? 0 : 128 - 64 * c), kmax = smp ? 144 : 192;
            float mx = sink; const LAS float* blp = bl + g * 256 - iq + 63;
#pragma unroll
            for (int kb = 0; kb < 6; ++kb)
#pragma unroll
                for (int e = 0; e < 16; ++e) { const int key = 32 * kb + (e & 3) + 8 * (e >> 2) + 4 * h; float s = st[kb][e] * 0.125f + blp[key]; if (key < kmin || key >= kmax) s = -1e30f; st[kb][e] = s; mx = fmaxf(mx, s); }
            mx = fmaxf(mx, __shfl_xor(mx, 32));
            float sum = 0.f;
#pragma unroll
            for (int kb = 0; kb < 6; ++kb)
#pragma unroll
                for (int e = 0; e < 16; ++e) { const float p = __expf(st[kb][e] - mx); st[kb][e] = p; sum += p; }
            sum += __shfl_xor(sum, 32); const float inv = 1.f / (sum + __expf(sink - mx));
            f32x16 o[2];
#pragma unroll
            for (int e = 0; e < 16; ++e) { o[0][e] = 0.f; o[1][e] = 0.f; }
#pragma unroll
            for (int kb = 0; kb < 6; ++kb)
#pragma unroll
                for (int s2 = 0; s2 < 2; ++s2) { u32x4 pw; pw.x = pk2(st[kb][8 * s2], st[kb][8 * s2 + 1]); pw.y = pk2(st[kb][8 * s2 + 2], st[kb][8 * s2 + 3]); pw.z = pk2(st[kb][8 * s2 + 4], st[kb][8 * s2 + 5]); pw.w = pk2(st[kb][8 * s2 + 6], st[kb][8 * s2 + 7]);
                    const bf16x8 pf = __builtin_bit_cast(bf16x8, pw);
#pragma unroll
                    for (int db = 0; db < 2; ++db) { const LAS bf16_t* vp = Vt + (32 * db + r) * 200 + 32 * kb + 16 * s2 + 4 * h; const u32x2 lo = *(const LAS u32x2*)vp, hi = *(const LAS u32x2*)(vp + 8);
                        u32x4 vw; vw.x = lo.x; vw.y = lo.y; vw.z = hi.x; vw.w = hi.y; o[db] = MFMA32(__builtin_bit_cast(bf16x8, vw), pf, o[db]); } }
#pragma unroll
            for (int db = 0; db < 2; ++db)
#pragma unroll
                for (int rg = 0; rg < 4; ++rg) { const int d0 = 32 * db + 8 * rg + 4 * h; f32x4 v = {o[db][4 * rg] * inv, o[db][4 * rg + 1] * inv, o[db][4 * rg + 2] * inv, o[db][4 * rg + 3] * inv};
                    *(u32x2*)(cat + (size_t)qrow * D + 512 + head * 64 + d0) = pack4(v); }
        }
        __syncthreads();
    }
    const int gt = blockIdx.x * 512 + tid, NT = gridDim.x * 512;
    for (int q = gt; q < MT * 64; q += NT) { const int m = q >> 6, c0 = (q & 63) * 8, wdw = 2 << (c0 >> 7); const bool smp = m >= MP; int b, t; if (!smp) { b = m >> 12; t = m & 4095; } else { b = (m - MP) >> 4; t = (m - MP) & 15; }
        float s[8], cur[8];
#pragma unroll
        for (int e = 0; e < 8; ++e) { s[e] = 0.f; cur[e] = 0.f; }
        for (int d = 0; d < wdw; ++d) { const int ts = t - d; float v[8];
            if (ts >= 0) { const u32x4 zz = *(const u32x4*)(z + (size_t)(m - d) * NIN + c0); v[0] = bflo(zz.x); v[1] = bfhi(zz.x); v[2] = bflo(zz.y); v[3] = bfhi(zz.y); v[4] = bflo(zz.z); v[5] = bfhi(zz.z); v[6] = bflo(zz.w); v[7] = bfhi(zz.w); }
            else if (smp) { const float* hp = a->in[2] + ((size_t)(i * NB_S + b) * 15 + 15 + ts) * 512 + c0; const f32x4 h0 = *(const f32x4*)hp, h1 = *(const f32x4*)(hp + 4); v[0] = h0[0]; v[1] = h0[1]; v[2] = h0[2]; v[3] = h0[3]; v[4] = h1[0]; v[5] = h1[1]; v[6] = h1[2]; v[7] = h1[3]; }
            else {
#pragma unroll
                for (int e = 0; e < 8; ++e) v[e] = 0.f; }
#pragma unroll
            for (int e = 0; e < 8; ++e) { s[e] += v[e]; if (d == 0) cur[e] = v[e]; } }
        const float rc = 1.f / (float)(smp ? wdw : (wdw < t + 1 ? wdw : t + 1));
        f32x4 o0, o1;
#pragma unroll
        for (int e = 0; e < 4; ++e) { o0[e] = s[e] * rc - cur[e]; o1[e] = s[4 + e] * rc - cur[4 + e]; }
        *(u32x4*)(cat + (size_t)m * D + c0) = pack8(o0, o1); }
    for (int q = gt; q < NB_P * 15 * 512; q += NT) { const int c = q & 511, rr = (q >> 9) % 15, b = q / (15 * 512); a->out[O_POOLP + (size_t)i * NB_P * 15 * 512 + q] = bflo((unsigned)z[(size_t)(b * SEQ + SEQ - 15 + rr) * NIN + c]); }
    for (int q = gt; q < NB_S * 15 * 512; q += NT) { const int c = q & 511, rr = (q >> 9) % 15, b = q / (15 * 512); a->out[O_POOLS + (size_t)i * NB_S * 15 * 512 + q] = bflo((unsigned)z[(size_t)(MP + b * LS + 1 + rr) * NIN + c]); }
    for (int q = gt; q < NB_P * 128 * 128; q += NT) { const int cd = q & 127, rr = (q >> 7) & 127, b = q >> 14; const bf16_t* p = z + (size_t)(b * SEQ + SEQ - 128 + rr) * NIN + 1024 + cd;
        a->out[O_KP + (size_t)i * NB_P * 16384 + q] = bflo((unsigned)p[0]); a->out[O_VP + (size_t)i * NB_P * 16384 + q] = bflo((unsigned)p[128]); }
    for (int q = gt; q < NB_S * 128 * 128; q += NT) { const int cd = q & 127, rr = (q >> 7) & 127, b = q >> 14; float kv, vv;
        if (rr < 112) { const size_t o = ((size_t)(i * NB_S + b) * 128 + rr + 16) * 128 + cd; kv = a->in[3][o]; vv = a->in[4][o]; }
        else { const bf16_t* p = z + (size_t)(MP + b * LS + rr - 112) * NIN + 1024 + cd; kv = bflo((unsigned)p[0]); vv = bflo((unsigned)p[128]); }
        a->out[O_KS + (size_t)i * NB_S * 16384 + q] = kv; a->out[O_VS + (size_t)i * NB_S * 16384 + q] = vv; }
}
__device__ __forceinline__ void phase_scan(ArgsP a, int l, LAS unsigned char* lds, const int tid) {
    const int i = l >> 1, lane = tid & 63, w = tid >> 6, rl = lane >> 3, cq = lane & 7, srow = 8 * w + rl;
    const bf16_t* R = (const bf16_t*)(a->ws + WS_R); const bf16_t* Kb = (const bf16_t*)(a->ws + WS_K); const bf16_t* Vb = (const bf16_t*)(a->ws + WS_V);
    const float* LD = (const float*)(a->ws + WS_LD); const bf16_t* AA = (const bf16_t*)(a->ws + WS_AA); const bf16_t* GG = (const bf16_t*)(a->ws + WS_G); bf16_t* AWO = (bf16_t*)(a->ws + WS_AWO);
    LAS float* Lnk = (LAS float*)lds; LAS float* Lde = Lnk + 2048; LAS float* Lbb = Lde + 2048; LAS float* Lkp = Lbb + 2048; LAS float* Lrr = Lkp + 2048; LAS float* Lvv = Lrr + 2048; LAS float* Lyy = Lvv + 2048; LAS float* Lbo = Lyy + 2048;
    const int ts_p = tid >> 4, cg4 = (tid & 15) * 4;
    for (int sq = blockIdx.x; sq < 64 + 128; sq += gridDim.x) {
        const bool smp = sq >= 64; int b, hd, L, row0;
        if (!smp) { b = sq >> 4; hd = sq & 15; L = SEQ; row0 = b * SEQ; } else { b = (sq - 64) >> 4; hd = sq & 15; L = LS; row0 = MP + b * LS; }
        float S[8];
        if (smp) { const float* sp = a->in[6] + ((size_t)((i * NB_S + b) * 16 + hd) * 64 + srow) * 64 + 8 * cq; const f32x4 s0 = *(const f32x4*)sp, s1 = *(const f32x4*)(sp + 4);
            S[0] = s0[0]; S[1] = s0[1]; S[2] = s0[2]; S[3] = s0[3]; S[4] = s1[0]; S[5] = s1[1]; S[6] = s1[2]; S[7] = s1[3]; }
        else {
#pragma unroll
            for (int e = 0; e < 8; ++e) S[e] = 0.f; }
        const int hc = hd * 64 + cg4;
        const f32x4 kk4 = *(const f32x4*)(a->in[30] + i * D + hc), ka4 = *(const f32x4*)(a->in[31] + i * D + hc), rk4 = *(const f32x4*)(a->in[32] + i * D + hc);
        const f32x4 lw4 = *(const f32x4*)(a->in[33] + i * D + hc), lb4 = *(const f32x4*)(a->in[34] + i * D + hc);
        for (int c0 = 0; c0 < L; c0 += 32) { const int T = (L - c0) < 32 ? (L - c0) : 32;
            if (ts_p < T) { const size_t m = (size_t)(row0 + c0 + ts_p); const u32x2 r2 = *(const u32x2*)(R + m * D + hc), k2 = *(const u32x2*)(Kb + m * D + hc), v2 = *(const u32x2*)(Vb + m * D + hc), a2 = *(const u32x2*)(AA + m * D + hc);
                const f32x4 ld4 = *(const f32x4*)(LD + m * D + hc);
                const f32x4 r4 = {bflo(r2.x), bfhi(r2.x), bflo(r2.y), bfhi(r2.y)}, k4 = {bflo(k2.x), bfhi(k2.x), bflo(k2.y), bfhi(k2.y)}, v4 = {bflo(v2.x), bfhi(v2.x), bflo(v2.y), bfhi(v2.y)}, a4 = {bflo(a2.x), bfhi(a2.x), bflo(a2.y), bfhi(a2.y)};
                f32x4 kk = k4 * kk4; float ssq = (kk[0] * kk[0] + kk[1] * kk[1]) + (kk[2] * kk[2] + kk[3] * kk[3]); ssq = red16(ssq); kk = kk * rsqrtf(fmaxf(ssq, 1e-24f));
                const f32x4 kp = k4 * (1.f + (a4 - 1.f) * ka4); f32x4 de;
#pragma unroll
                for (int e = 0; e < 4; ++e) de[e] = __expf(ld4[e]);
                float bo = (r4[0] * kp[0] * rk4[0] + r4[1] * kp[1] * rk4[1]) + (r4[2] * kp[2] * rk4[2] + r4[3] * kp[3] * rk4[3]); bo = red16(bo);
                const int o = ts_p * 64 + cg4;
                *(LAS f32x4*)(Lnk + o) = -kk; *(LAS f32x4*)(Lde + o) = de; *(LAS f32x4*)(Lbb + o) = kk * a4; *(LAS f32x4*)(Lkp + o) = kp; *(LAS f32x4*)(Lrr + o) = r4; *(LAS f32x4*)(Lvv + o) = v4;
                if ((tid & 15) == 0) Lbo[ts_p] = bo; }
            __syncthreads();
            for (int ts = 0; ts < T; ++ts) { const int o = ts * 64 + 8 * cq;
                const f32x4 n0 = *(const LAS f32x4*)(Lnk + o), n1 = *(const LAS f32x4*)(Lnk + o + 4), d0 = *(const LAS f32x4*)(Lde + o), d1 = *(const LAS f32x4*)(Lde + o + 4), b0 = *(const LAS f32x4*)(Lbb + o), b1 = *(const LAS f32x4*)(Lbb + o + 4);
                const f32x4 p0 = *(const LAS f32x4*)(Lkp + o), p1 = *(const LAS f32x4*)(Lkp + o + 4), r0 = *(const LAS f32x4*)(Lrr + o), r1 = *(const LAS f32x4*)(Lrr + o + 4); const float vi = Lvv[ts * 64 + srow];
                float sa = (S[0] * n0[0] + S[1] * n0[1]) + (S[2] * n0[2] + S[3] * n0[3]) + (S[4] * n1[0] + S[5] * n1[1]) + (S[6] * n1[2] + S[7] * n1[3]); sa = red8(sa);
#pragma unroll
                for (int e = 0; e < 4; ++e) { S[e] = S[e] * d0[e] + sa * b0[e] + vi * p0[e]; S[4 + e] = S[4 + e] * d1[e] + sa * b1[e] + vi * p1[e]; }
                float y = (S[0] * r0[0] + S[1] * r0[1]) + (S[2] * r0[2] + S[3] * r0[3]) + (S[4] * r1[0] + S[5] * r1[1]) + (S[6] * r1[2] + S[7] * r1[3]); y = red8(y);
                if (cq == 0) Lyy[ts * 64 + srow] = y; }
            __syncthreads();
            if (ts_p < T) { const size_t m = (size_t)(row0 + c0 + ts_p); const int o = ts_p * 64 + cg4; const f32x4 y4 = *(const LAS f32x4*)(Lyy + o), v4 = *(const LAS f32x4*)(Lvv + o); const float bo = Lbo[ts_p];
                const u32x2 g2 = *(const u32x2*)(GG + m * D + hc); const f32x4 g4 = {bflo(g2.x), bfhi(g2.x), bflo(g2.y), bfhi(g2.y)};
                const float mean = red16((y4[0] + y4[1]) + (y4[2] + y4[3])) * (1.f / 64.f); const f32x4 dv = y4 - mean;
                const float var = red16((dv[0] * dv[0] + dv[1] * dv[1]) + (dv[2] * dv[2] + dv[3] * dv[3])) * (1.f / 64.f); const float rs = rsqrtf(var + 64e-5f);
                const f32x4 yn = dv * rs * lw4 + lb4; f32x4 ob = yn + v4 * bo;
                *(u32x2*)(AWO + m * D + hc) = pack4(ob * g4); }
            __syncthreads();
        }
        float* so = a->out + (smp ? O_WKVS + (size_t)((i * NB_S + b) * 16 + hd) * 4096 : O_WKVP + (size_t)((i * NB_P + b) * 16 + hd) * 4096) + srow * 64 + 8 * cq;
        *(f32x4*)so = (f32x4){S[0], S[1], S[2], S[3]}; *(f32x4*)(so + 4) = (f32x4){S[4], S[5], S[6], S[7]};
    }
}
#ifndef SKIP_SG
#define SKIP_SG 0
#endif
#define GEMM_P(EPI, Aptr, Bptr, NN, KK, E) do { int kk_ = (KK), nn_ = (NN); asm volatile("" : "+s"(kk_), "+s"(nn_)); pg8::Gemm g_{(const bf16_t*)(Aptr), (const bf16_t*)(Bptr), MP, nn_, kk_}; pg8::StaticOrder S_; int bid_ = blockIdx.x; asm volatile("" : "+s"(bid_)); S_.init(MP, nn_, (int)gridDim.x, bid_); \
    pg8::gemm_phase<EPI, pg8::StaticOrder, true, true>(lds, g_, S_, (E), mk_tid(wave_s)); } while (0)
__global__ void __launch_bounds__(512, 2) mega_fwd(Args a_unused) {
    extern __shared__ __attribute__((aligned(16))) unsigned char lds_raw[];
    LAS unsigned char* lds = (LAS unsigned char*)lds_raw;
    cg::grid_group grid = cg::this_grid();
    ArgsP a = (ArgsP)__builtin_amdgcn_kernarg_segment_ptr();
    const int wave_s = __builtin_amdgcn_readfirstlane((int)threadIdx.x >> 6);
#define RELOAD() asm volatile("" : "+s"(a))
    constexpr size_t RKV_STRIDE = (33 * MiB) / 2;
#ifndef NO_INIT
    phase_init(a, mk_tid(wave_s));
#endif
    grid.sync();
    for (int l = 0; l < 4; ++l) {
        RELOAD();
#ifndef NO_CONV
        convert_layer(a, l, lds, mk_tid(wave_s));
#endif
        grid.sync();
        for (int part = 0; part < 3; ++part) {
            RELOAD();
            unsigned char* ws = a->ws; bf16_t* W = (bf16_t*)(ws + WS_W); float* x = a->out; bf16_t* xb = (bf16_t*)(ws + WS_XB); float* ss = (float*)(ws + WS_SS); float* xs = x + (size_t)MP * D;
            const bf16_t* rA; const bf16_t* rB; int rK, rKc; float rscale;
            if (part != 1) { const int j = part >> 1; const bf16_t* Wgu = W + (j ? WE_GU1 : WE_GU0); const float* ssk = ss + (size_t)((3 * l + part) & 1) * MP * 16; bf16_t* act = (bf16_t*)(ws + WS_A0);
                { EpiSwiglu E{ssk, act}; GEMM_P(EpiSwiglu, xb, Wgu, NGU, D, E); }
                if (!SKIP_SG) sgemm<2>(mk_tid(wave_s), 176, 1, D, Wgu, D, ALx{xs}, SEpiSwiglu{act + (size_t)MP * FF});
                grid.sync();
                rA = act; rB = W + (j ? WE_DN1 : WE_DN0); rK = FF; rKc = 352; rscale = 0.5f;
            } else if ((l & 1) == 0) { const float* ssk = ss + (size_t)((3 * l + 1) & 1) * MP * 16; bf16_t* z = (bf16_t*)(ws + WS_Z);
                { EpiZ E{ssk, z}; GEMM_P(EpiZ, xb, W + WE_IN, NIN, D, E); }
                if (!SKIP_SG) sgemm<2>(mk_tid(wave_s), 40, 1, D, W + WE_IN, D, ALx{xs}, SEpiZ{z + (size_t)MP * NIN});
                grid.sync();
#ifndef NO_ATTN
                phase_attn(a, l >> 1, lds, mk_tid(wave_s));
#endif
                grid.sync();
                rA = (const bf16_t*)(ws + WS_CAT); rB = W + WE_OUT; rK = D; rKc = 128; rscale = 1.f;
            } else {
#ifndef NO_SHIFT
                phase_shift(a, l, mk_tid(wave_s));
#endif
                grid.sync();
                { bf16_t* hh = (bf16_t*)(ws + WS_HH); bf16_t* rkv = (bf16_t*)(ws + WS_R); bf16_t* lora = (bf16_t*)(ws + WS_LORA);
                  { EpiRkvl E{rkv, RKV_STRIDE, lora}; GEMM_P(EpiRkvl, hh, W + WE_RKVL, NRKVL, 2048, E); }
                  if (!SKIP_SG) sgemm<2>(mk_tid(wave_s), 104, 1, 2048, W + WE_RKVL, 2048, ALbf16{hh + (size_t)MP * 2048, 2048}, SEpiRkvl{rkv + (size_t)MP * D, RKV_STRIDE, lora + (size_t)MP * 256}); }
                grid.sync();
                { const int i = l >> 1; bf16_t* lora = (bf16_t*)(ws + WS_LORA); float* ldp = (float*)(ws + WS_LD); bf16_t* aa = (bf16_t*)(ws + WS_AA); bf16_t* gg = (bf16_t*)(ws + WS_G);
                  const float* w0 = a->in[22] + i * D; const float* a0 = a->in[25] + i * D;
                  { EpiWag E{w0, a0, ldp, aa, gg}; GEMM_P(EpiWag, lora, W + WE_WAG, NWAG, 256, E); }
                  if (!SKIP_SG) sgemm<2>(mk_tid(wave_s), 96, 1, 256, W + WE_WAG, 256, ALbf16{lora + (size_t)MP * 256, 256}, SEpiWag{w0, a0, ldp + (size_t)MP * D, aa + (size_t)MP * D, gg + (size_t)MP * D}); }
                grid.sync();
#ifndef NO_SCAN
                phase_scan(a, l, lds, mk_tid(wave_s));
#endif
                grid.sync();
                rA = (const bf16_t*)(ws + WS_AWO); rB = W + WE_WO; rK = D; rKc = 128; rscale = 1.f;
            }
            { EpiResid E{x, xb, ss + (size_t)((3 * l + part + 1) & 1) * MP * 16, rscale}; GEMM_P(EpiResid, rA, rB, D, rK, E); }
            if (!SKIP_SG) sgemm_resid(mk_tid(wave_s), lds, rA + (size_t)MP * rK, rB, rK, xs, rscale);
            grid.sync();
        }
    }
    RELOAD();
#ifndef NO_FINAL
    phase_final(a, mk_tid(wave_s));
#endif
}
extern "C" void kernel_launch(void* const* d_in, const int* in_sizes, int n_in, void* d_out, int out_size, void* d_ws, size_t ws_size, hipStream_t stream) {
    static int grid = 0;
    if (grid == 0) {
        int dev = 0, cus = 0, per_cu = 0;
        if (n_in != 37 || out_size != (int)O_END || ws_size < WS_END) { fprintf(stderr, "kernel_launch: unexpected shapes: n_in %d out %d ws %zu (need %zu)\n", n_in, out_size, ws_size, (size_t)WS_END); grid = -1; return; }
        hipGetDevice(&dev); hipDeviceGetAttribute(&cus, hipDeviceAttributeMultiprocessorCount, dev);
        if (hipFuncSetAttribute((const void*)mega_fwd, hipFuncAttributeMaxDynamicSharedMemorySize, LDS_BYTES) != hipSuccess) { fprintf(stderr, "kernel_launch: hipFuncSetAttribute failed\n"); grid = -1; return; }
        hipOccupancyMaxActiveBlocksPerMultiprocessor(&per_cu, (const void*)mega_fwd, 512, LDS_BYTES);
        (void)hipGetLastError();
        if (per_cu < 1) per_cu = 1;
        grid = cus;
        fprintf(stderr, "kernel_launch: cus %d per_cu %d grid %d\n", cus, per_cu, grid);
    }
    if (grid < 0) return;
    Args a{};
    for (int i = 0; i < 37; ++i) a.in[i] = (const float*)d_in[i];
    a.out = (float*)d_out; a.ws = (unsigned char*)d_ws; a.ph_lo = 0; a.ph_hi = 0;
    void* args[] = {&a};
    hipError_t e = hipLaunchCooperativeKernel((const void*)mega_fwd, dim3(grid), dim3(512), args, LDS_BYTES, stream);
    if (e != hipSuccess) fprintf(stderr, "kernel_launch: cooperative launch failed: %s\n", hipGetErrorString(e));
}
```

```cpp
#include <hip/hip_runtime.h>
#include <hip/hip_cooperative_groups.h>
#include <cstdio>
#include <cstdint>
namespace cg = cooperative_groups;
namespace pg8 {
#define PG8_LAS __attribute__((address_space(3)))
typedef unsigned short bf16_t;
typedef short bf16x8 __attribute__((ext_vector_type(8)));
typedef float f32x4 __attribute__((ext_vector_type(4)));
typedef unsigned u32x4 __attribute__((ext_vector_type(4)));
constexpr int BM = 256, BK = 64, HALF = 128, HTB = HALF * BK * 2  , STAGE_BYTES = 8 * HTB, NXCD = 8, WGM = 8;

__host__ __device__ __forceinline__ int lds_byte(int r, int c) { const int st = (r >> 4) * 2 + (c >> 5), rr = r & 15, cc = c & 31, ob = rr * 64 + cc * 2; return st * 1024 + (ob ^ (((ob >> 9) & 1) << 5)); }
__host__ __device__ __forceinline__ void stage_rc(int b, int& R, int& C) { const int st = b / 1024, sb = b % 1024, swz = sb ^ (((sb >> 9) & 1) << 5); R = (st >> 1) * 16 + swz / 64; C = (st & 1) * 32 + (swz % 64) / 2; }
__host__ __device__ __forceinline__ int perm32(int rho) { const int n = rho >> 4, i = rho & 15; return 8 * (i >> 2) + 4 * n + (i & 3); }

struct Unit { int pm, pn; };
struct Gemm { const bf16_t* A; const bf16_t* Bt; int M, N, K; };

struct StaticOrder {
    int nM, nN, nwg, G, c;
    __host__ __device__ void init(int M, int N, int G_, int c_) { nM = M / BM; nN = N / BM; nwg = nM * nN; G = G_; c = c_; }
    __host__ __device__ bool next(int i, Unit& u) const {
        const long L = (long)i * G + c; if (L >= nwg) return false;
        int wgid = (int)L; { const int q = nwg / NXCD, r = nwg % NXCD, xcd = wgid % NXCD, off = wgid / NXCD; wgid = (xcd < r ? xcd * (q + 1) : r * (q + 1) + (xcd - r) * q) + off; }
        const int nig = WGM * nN, gid = wgid / nig, fm = gid * WGM, gsz = (nM - fm) < WGM ? (nM - fm) : WGM;
        u.pm = fm + ((wgid % nig) % gsz); u.pn = (wgid % nig) / gsz; return true;
    }
    __device__ __forceinline__ void a_ready(const Unit&) const {}
    __device__ __forceinline__ void done(const Unit&) const {}
};

typedef float f32x2 __attribute__((ext_vector_type(2)));
template <class Epi, class Sched, bool ALIGN_EPI = false, bool SP2 = false>
__device__ __forceinline__ void gemm_phase(PG8_LAS unsigned char* lds, const Gemm g, const Sched& S, const Epi& E, int tid_in) {
    int tid_ = tid_in; asm volatile("" : "+v"(tid_));
    const int tid = tid_, wid = __builtin_amdgcn_readfirstlane(tid >> 6), lane = tid & 63, wr = wid >> 2, wc = wid & 3, fr = lane & 15, fq = lane >> 4;
    const int K = g.K, nt = K / BK;
    unsigned voffA[2], voffB[2];
#pragma unroll
    for (int i = 0; i < 2; ++i) { int R, C; stage_rc(tid * 16 + i * 8192, R, C); const int Rb = Epi::PERM ? ((R & ~31) + perm32(R & 31)) : R;
        voffA[i] = (unsigned)(R * K + C) * 2u; voffB[i] = (unsigned)(Rb * K + C) * 2u; }
    const size_t kstep = (size_t)(BK * 2);
    const size_t hstep = (size_t)HALF * K * 2;
    const size_t tstep = 2 * hstep;
    const unsigned ldsw = (unsigned)wid * 1024u;
    const int aoff = lds_byte(wr * 64 + fr, fq * 8), boff = lds_byte(wc * 32 + fr, fq * 8);
#define PG8_SA(b, h) (((b) * 2 + (h)) * HTB)
#define PG8_SB(b, h) ((4 + (b) * 2 + (h)) * HTB)
#define PG8_STAGE(bufoff, gbase, voff) do { _Pragma("unroll") for (int _i = 0; _i < 2; ++_i) \
        __builtin_amdgcn_global_load_lds((const unsigned*)((const char*)(gbase) + (voff)[_i]), (PG8_LAS unsigned*)(lds + (bufoff) + ldsw + _i * 8192), 16, 0, 0); } while (0)
#define PG8_LDA(dst, b, h) do { _Pragma("unroll") for (int m = 0; m < 4; ++m) _Pragma("unroll") for (int k = 0; k < 2; ++k) dst[m][k] = *(const PG8_LAS bf16x8*)(lds + PG8_SA(b, h) + aoff + m * 2048 + k * 1024); } while (0)
#define PG8_LDB(dst, b, h) do { _Pragma("unroll") for (int n = 0; n < 2; ++n) _Pragma("unroll") for (int k = 0; k < 2; ++k) dst[n][k] = *(const PG8_LAS bf16x8*)(lds + PG8_SB(b, h) + boff + n * 2048 + k * 1024); } while (0)
#define PG8_MMA(ai, bj, At, Bt) do { __builtin_amdgcn_s_setprio(1); _Pragma("unroll") for (int m = 0; m < 4; ++m) _Pragma("unroll") for (int n = 0; n < 2; ++n) _Pragma("unroll") for (int k = 0; k < 2; ++k) \
        acc[ai][bj][m][n] = __builtin_amdgcn_mfma_f32_16x16x32_bf16(Bt[n][k], At[m][k], acc[ai][bj][m][n], 0, 0, 0); __builtin_amdgcn_s_setprio(0); } while (0)
#define PG8_WAIT_V(n) asm volatile("s_waitcnt vmcnt(" #n ")" ::: "memory")
#define PG8_WAIT_L(n) asm volatile("s_waitcnt lgkmcnt(" #n ")" ::: "memory")
#define PG8_BAR __builtin_amdgcn_s_barrier()
#define PG8_SCHED __builtin_amdgcn_sched_barrier(0)
    Unit cur, nxt; int ui = 0;
    if (!S.next(0, cur)) return;
    f32x4 acc[2][2][4][2];
#pragma unroll
    for (int a = 0; a < 2; ++a)
#pragma unroll
        for (int b = 0; b < 2; ++b)
#pragma unroll
            for (int m = 0; m < 4; ++m)
#pragma unroll
                for (int n = 0; n < 2; ++n) acc[a][b][m][n] = (f32x4){0.f, 0.f, 0.f, 0.f};
    bf16x8 At[4][2], B0[2][2], B1[2][2];
    const char* cA = (const char*)g.A + (size_t)cur.pm * tstep; const char* cB = (const char*)g.Bt + (size_t)cur.pn * tstep;
    S.a_ready(cur);
    if constexpr (SP2) {
        PG8_STAGE(PG8_SB(0, 0), cB, voffB); PG8_STAGE(PG8_SB(0, 1), cB + hstep, voffB); PG8_STAGE(PG8_SA(0, 0), cA, voffA); PG8_STAGE(PG8_SA(0, 1), cA + hstep, voffA);
        if (wr == 1) PG8_BAR;
        PG8_WAIT_V(2); PG8_BAR;
        PG8_STAGE(PG8_SB(1, 0), cB + kstep, voffB); PG8_STAGE(PG8_SA(1, 0), cA + kstep, voffA); PG8_STAGE(PG8_SB(1, 1), cB + hstep + kstep, voffB);
        PG8_WAIT_V(6); PG8_BAR;
    } else {
        PG8_STAGE(PG8_SB(0, 0), cB, voffB); PG8_STAGE(PG8_SA(0, 0), cA, voffA); PG8_STAGE(PG8_SB(0, 1), cB + hstep, voffB); PG8_STAGE(PG8_SA(0, 1), cA + hstep, voffA);
        if (wr == 1) PG8_BAR;
        PG8_WAIT_V(4); PG8_BAR;
        PG8_STAGE(PG8_SB(1, 0), cB + kstep, voffB); PG8_STAGE(PG8_SA(1, 0), cA + kstep, voffA); PG8_STAGE(PG8_SB(1, 1), cB + hstep + kstep, voffB);
        PG8_WAIT_V(6); PG8_BAR;
    }
    for (;;) {
        const bool has_next = S.next(ui + 1, nxt);
        const char* nA = has_next ? (const char*)g.A + (size_t)nxt.pm * tstep : cA; const char* nB = has_next ? (const char*)g.Bt + (size_t)nxt.pn * tstep : cB;
        for (int t = 0; t < nt; t += 2) {
            const bool last = (t == nt - 2);
            const char* a1 = cA + (size_t)(t + 1) * kstep;
            const char* a2 = last ? nA : cA + (size_t)(t + 2) * kstep; const char* b2 = last ? nB : cB + (size_t)(t + 2) * kstep;
            const char* a3 = a2 + kstep; const char* b3 = b2 + kstep;
            if (last && has_next) S.a_ready(nxt);
            if constexpr (SP2) {
            PG8_LDB(B0, 0, 0); PG8_LDB(B1, 0, 1); PG8_SCHED; PG8_LDA(At, 0, 0); PG8_STAGE(PG8_SA(1, 1), a1 + hstep, voffA);
            PG8_WAIT_V(8); PG8_WAIT_L(0); PG8_BAR; PG8_MMA(0, 0, At, B0); PG8_MMA(0, 1, At, B1); PG8_BAR; PG8_SCHED;
            PG8_LDA(At, 0, 1); PG8_STAGE(PG8_SB(0, 0), b2, voffB); PG8_STAGE(PG8_SB(0, 1), b2 + hstep, voffB); PG8_STAGE(PG8_SA(0, 0), a2, voffA);
            PG8_WAIT_V(8); PG8_WAIT_L(0); PG8_BAR; PG8_MMA(1, 0, At, B0); PG8_MMA(1, 1, At, B1); PG8_BAR; PG8_SCHED;
            PG8_LDB(B0, 1, 0); PG8_LDB(B1, 1, 1); PG8_SCHED; PG8_LDA(At, 1, 0); PG8_STAGE(PG8_SA(0, 1), a2 + hstep, voffA);
            PG8_WAIT_V(8); PG8_WAIT_L(0); PG8_BAR; PG8_MMA(0, 0, At, B0); PG8_MMA(0, 1, At, B1); PG8_BAR; PG8_SCHED;
            PG8_LDA(At, 1, 1); PG8_STAGE(PG8_SB(1, 0), b3, voffB); PG8_STAGE(PG8_SB(1, 1), b3 + hstep, voffB); PG8_STAGE(PG8_SA(1, 0), a3, voffA);
            PG8_WAIT_V(8); PG8_WAIT_L(0); PG8_BAR; PG8_MMA(1, 0, At, B0); PG8_MMA(1, 1, At, B1); PG8_BAR; PG8_SCHED;
            } else {
            PG8_LDB(B0, 0, 0); PG8_SCHED; PG8_LDA(At, 0, 0); PG8_STAGE(PG8_SA(1, 1), a1 + hstep, voffA);
            PG8_WAIT_L(8); PG8_BAR; PG8_WAIT_L(0); PG8_MMA(0, 0, At, B0); PG8_BAR; PG8_SCHED;
            PG8_LDB(B1, 0, 1); PG8_STAGE(PG8_SB(0, 0), b2, voffB);
            PG8_BAR; PG8_WAIT_L(0); PG8_MMA(0, 1, At, B1); PG8_BAR;
            PG8_LDA(At, 0, 1); PG8_STAGE(PG8_SA(0, 0), a2, voffA);
            PG8_BAR; PG8_WAIT_L(0); PG8_MMA(1, 0, At, B0); PG8_BAR; PG8_SCHED;
            PG8_STAGE(PG8_SB(0, 1), b2 + hstep, voffB);
            PG8_WAIT_V(6); PG8_BAR; PG8_MMA(1, 1, At, B1); PG8_BAR;
            PG8_LDB(B0, 1, 0); PG8_SCHED; PG8_LDA(At, 1, 0); PG8_STAGE(PG8_SA(0, 1), a2 + hstep, voffA);
            PG8_WAIT_L(8); PG8_BAR; PG8_WAIT_L(0); PG8_MMA(0, 0, At, B0); PG8_BAR; PG8_SCHED;
            PG8_LDB(B1, 1, 1); PG8_STAGE(PG8_SB(1, 0), b3, voffB);
            PG8_BAR; PG8_WAIT_L(0); PG8_MMA(0, 1, At, B1); PG8_BAR;
            PG8_LDA(At, 1, 1); PG8_STAGE(PG8_SA(1, 0), a3, voffA);
            PG8_BAR; PG8_WAIT_L(0); PG8_MMA(1, 0, At, B0); PG8_BAR; PG8_SCHED;
            PG8_STAGE(PG8_SB(1, 1), b3 + hstep, voffB);
            PG8_WAIT_V(6); PG8_BAR; PG8_MMA(1, 1, At, B1); PG8_BAR;
            }
        }
        if constexpr (ALIGN_EPI) { if (wr == 0) PG8_BAR; }
        if constexpr (!Epi::AFTER_DRAIN) { E(acc, cur, wr, wc, fr, fq); S.done(cur); }
        if (!has_next) break;
#pragma unroll
        for (int a = 0; a < 2; ++a)
#pragma unroll
            for (int b = 0; b < 2; ++b)
#pragma unroll
                for (int m = 0; m < 4; ++m)
#pragma unroll
                    for (int n = 0; n < 2; ++n) acc[a][b][m][n] = (f32x4){0.f, 0.f, 0.f, 0.f};
        cur = nxt; cA = nA; cB = nB; ++ui;
        if constexpr (ALIGN_EPI) { if (wr == 1) PG8_BAR; }
    }
    PG8_WAIT_V(0);
    if constexpr (!ALIGN_EPI) { if (wr == 0) PG8_BAR; }
    PG8_BAR;
    if constexpr (Epi::AFTER_DRAIN) { E.fused(acc, cur, wr, wc, fr, fq, lds, wid, lane); S.done(cur); }
#undef PG8_SA
#undef PG8_SB
#undef PG8_STAGE
#undef PG8_LDA
#undef PG8_LDB
#undef PG8_MMA
#undef PG8_WAIT_V
#undef PG8_WAIT_L
#undef PG8_BAR
#undef PG8_SCHED
}
}
using pg8::bf16_t; using pg8::bf16x8; using pg8::f32x4;
typedef float f32x16 __attribute__((ext_vector_type(16)));
typedef unsigned u32x4 __attribute__((ext_vector_type(4)));
typedef unsigned u32x2 __attribute__((ext_vector_type(2)));
typedef short s16x4 __attribute__((ext_vector_type(4)));
#define LAS __attribute__((address_space(3)))
constexpr int MP = 16384, MS = 128, MT = 16512, D = 1024, FF = 2816, NGU = 5632, NIN = 1280, NRKVL = 3328, NWAG = 3072;
constexpr int SEQ = 4096, NB_P = 4, NB_S = 8, LS = 16;
constexpr size_t MiB = 1u << 20;
constexpr size_t WE_GU0 = 0, WE_DN0 = WE_GU0 + (size_t)NGU * D, WE_GU1 = WE_DN0 + (size_t)D * FF, WE_DN1 = WE_GU1 + (size_t)NGU * D, WE_MIX = WE_DN1 + (size_t)D * FF;
constexpr size_t WE_IN = WE_MIX, WE_OUT = WE_IN + (size_t)NIN * D;
constexpr size_t WE_RKVL = WE_MIX, WE_WAG = WE_RKVL + (size_t)NRKVL * 2048, WE_WO = WE_WAG + (size_t)NWAG * 256, WE_END = WE_WO + (size_t)D * D;
static_assert(WE_END * 2 <= 50 * MiB, "weights region");
constexpr size_t WS_W = 0, WS_XB = 50 * MiB  , WS_WEFF = 83 * MiB, WS_SS = 87 * MiB, WS_A0 = 89 * MiB, WS_B2 = 178 * MiB, WS_B3 = 286 * MiB, WS_BAR = 385 * MiB, WS_END = 386 * MiB;
constexpr size_t WS_Z = WS_A0, WS_CAT = WS_A0 + 41 * MiB, WS_HH = WS_A0, WS_LD = WS_A0;
constexpr size_t WS_R = WS_B2, WS_K = WS_B2 + 33 * MiB, WS_V = WS_B2 + 66 * MiB, WS_LORA = WS_B2 + 99 * MiB;
constexpr size_t WS_AA = WS_B3, WS_G = WS_B3 + 33 * MiB, WS_AWO = WS_B3 + 66 * MiB;
static_assert((size_t)MT * FF * 2 <= 89 * MiB && (size_t)MT * NIN * 2 <= 41 * MiB && (size_t)MT * D * 2 <= 33 * MiB && (size_t)MT * 256 * 2 <= 9 * MiB && (size_t)MT * D * 4 <= 89 * MiB, "arena");
constexpr size_t O_Y = 0, O_POOLP = 16908288, O_POOLS = 16969728, O_KP = 17092608, O_KS = 17223680, O_VP = 17485824, O_VS = 17616896, O_SHP = 17879040, O_SHS = 17887232, O_WKVP = 17903616, O_WKVS = 18427904, O_END = 19476480;
constexpr int LDS_BYTES = 131072 + 1024;

struct Args { const float* in[37]; float* out; unsigned char* ws; int ph_lo, ph_hi; };
typedef const __attribute__((address_space(4))) Args* ArgsP;

__device__ __forceinline__ unsigned pk2(float lo, float hi) { typedef float f2 __attribute__((ext_vector_type(2))); typedef __bf16 b2 __attribute__((ext_vector_type(2))); f2 v = {lo, hi}; b2 b = __builtin_convertvector(v, b2); return __builtin_bit_cast(unsigned, b); }
__device__ __forceinline__ int mk_tid(int wave_s) { unsigned ones = ~0u; asm volatile("" : "+s"(ones)); const int lane = __builtin_amdgcn_mbcnt_hi(ones, __builtin_amdgcn_mbcnt_lo(ones, 0u)); return wave_s * 64 + lane; }
__device__ __forceinline__ float bflo(unsigned u) { return __builtin_bit_cast(float, u << 16); }
__device__ __forceinline__ float bfhi(unsigned u) { return __builtin_bit_cast(float, u & 0xffff0000u); }
__device__ __forceinline__ float sigmoidf_(float x) { return 1.f / (1.f + __expf(-x)); }
__device__ __forceinline__ float wave_sum(float v) {
#pragma unroll
    for (int o = 1; o < 64; o <<= 1) v += __shfl_xor(v, o);
    return v;
}
template <int CTRL> __device__ __forceinline__ float dpp_f(float v) { return __builtin_bit_cast(float, __builtin_amdgcn_update_dpp(0, __builtin_bit_cast(int, v), CTRL, 0xF, 0xF, true)); }
__device__ __forceinline__ float red8(float v) { v += dpp_f<0xB1>(v); v += dpp_f<0x4E>(v); v += dpp_f<0x141>(v); return v; }
__device__ __forceinline__ float red16(float v) { v = red8(v); v += dpp_f<0x140>(v); return v; }
__device__ __forceinline__ float ss_rstd(const float* ssrow) { const f32x4 a = *(const f32x4*)ssrow, b = *(const f32x4*)(ssrow + 4), c = *(const f32x4*)(ssrow + 8), d = *(const f32x4*)(ssrow + 12);
    const float s = ((a[0] + a[1]) + (a[2] + a[3])) + ((b[0] + b[1]) + (b[2] + b[3])) + ((c[0] + c[1]) + (c[2] + c[3])) + ((d[0] + d[1]) + (d[2] + d[3])); return rsqrtf(s * (1.f / D) + 1e-6f); }
__device__ __forceinline__ u32x4 pack8(const f32x4& a, const f32x4& b) { u32x4 w; w.x = pk2(a[0], a[1]); w.y = pk2(a[2], a[3]); w.z = pk2(b[0], b[1]); w.w = pk2(b[2], b[3]); return w; }
__device__ __forceinline__ u32x2 pack4(const f32x4& a) { u32x2 w; w.x = pk2(a[0], a[1]); w.y = pk2(a[2], a[3]); return w; }

#define EPI_LOOP_ROWS for (int am_ = 0; am_ < 8; ++am_)
#define EPI_AM const int ai = am_ >> 2, m = am_ & 3;
struct EpiSwiglu {
    static constexpr bool PERM = true, AFTER_DRAIN = false;
    const float* ss; bf16_t* act;
    __device__ __forceinline__ void operator()(const f32x4 (&acc)[2][2][4][2], const pg8::Unit& u, int wr, int wc, int fr, int fq) const { asm volatile("" : "+v"(fr), "+v"(fq));
#pragma unroll
        EPI_LOOP_ROWS { EPI_AM const int row = u.pm * 256 + ai * 128 + wr * 64 + m * 16 + fr; const float rstd = ss_rstd(ss + (size_t)row * 16);
#pragma unroll
            for (int bj = 0; bj < 2; ++bj) { const int col0 = u.pn * 256 + bj * 128 + wc * 32 + 8 * fq; const f32x4 g = acc[ai][bj][m][0] * rstd, up = acc[ai][bj][m][1] * rstd; f32x4 o;
#pragma unroll
                for (int j = 0; j < 4; ++j) o[j] = g[j] * sigmoidf_(g[j]) * up[j];
                *(u32x2*)(act + (size_t)row * FF + (col0 >> 1)) = pack4(o); } }
    }
};
struct EpiResid {
    static constexpr bool PERM = true, AFTER_DRAIN = false;
    float* x; bf16_t* xb; float* ssn; float scale;
    __device__ __forceinline__ void operator()(const f32x4 (&acc)[2][2][4][2], const pg8::Unit& u, int wr, int wc, int fr, int fq) const { asm volatile("" : "+v"(fr), "+v"(fq));
#pragma unroll
        EPI_LOOP_ROWS { EPI_AM const int row = u.pm * 256 + ai * 128 + wr * 64 + m * 16 + fr; float sq = 0.f;
#pragma unroll
            for (int bj = 0; bj < 2; ++bj) { const int col0 = u.pn * 256 + bj * 128 + wc * 32 + 8 * fq; float* xp = x + (size_t)row * D + col0;
                f32x4 x0 = *(const f32x4*)xp, x1 = *(const f32x4*)(xp + 4); x0 += acc[ai][bj][m][0] * scale; x1 += acc[ai][bj][m][1] * scale;
                *(f32x4*)xp = x0; *(f32x4*)(xp + 4) = x1; *(u32x4*)(xb + (size_t)row * D + col0) = pack8(x0, x1);
                sq += (x0[0] * x0[0] + x0[1] * x0[1]) + (x0[2] * x0[2] + x0[3] * x0[3]) + (x1[0] * x1[0] + x1[1] * x1[1]) + (x1[2] * x1[2] + x1[3] * x1[3]); }
            sq += __shfl_xor(sq, 16); sq += __shfl_xor(sq, 32);
            if (fq == 0) ssn[(size_t)row * 16 + u.pn * 4 + wc] = sq; }
    }
};
struct EpiZ {
    static constexpr bool PERM = true, AFTER_DRAIN = false;
    const float* ss; bf16_t* z;
    __device__ __forceinline__ void operator()(const f32x4 (&acc)[2][2][4][2], const pg8::Unit& u, int wr, int wc, int fr, int fq) const { asm volatile("" : "+v"(fr), "+v"(fq));
#pragma unroll
        EPI_LOOP_ROWS { EPI_AM const int row = u.pm * 256 + ai * 128 + wr * 64 + m * 16 + fr; const float rstd = ss_rstd(ss + (size_t)row * 16);
#pragma unroll
            for (int bj = 0; bj < 2; ++bj) { const int col0 = u.pn * 256 + bj * 128 + wc * 32 + 8 * fq;
                *(u32x4*)(z + (size_t)row * NIN + col0) = pack8(acc[ai][bj][m][0] * rstd, acc[ai][bj][m][1] * rstd); } }
    }
};
__device__ __forceinline__ float lora_act(float v, int c) { return c < 64 ? (1.f - 2.f / (__expf(2.f * v) + 1.f)) : (c < 128 ? v : sigmoidf_(v)); }
struct EpiRkvl {
    static constexpr bool PERM = true, AFTER_DRAIN = false;
    bf16_t* rkv; size_t stride; bf16_t* lora;
    __device__ __forceinline__ void operator()(const f32x4 (&acc)[2][2][4][2], const pg8::Unit& u, int wr, int wc, int fr, int fq) const { asm volatile("" : "+v"(fr), "+v"(fq));
        const int t = u.pn >> 2; const int rb = u.pm * 256 + wr * 64 + fr, cb = wc * 32 + 8 * fq;
        if (t < 3) { bf16_t* base = rkv + t * stride + (size_t)rb * D + (u.pn & 3) * 256 + cb;
#pragma unroll
            for (int am_ = 0; am_ < 8; ++am_) { const int ai = am_ >> 2, m = am_ & 3;
#pragma unroll
                for (int bj = 0; bj < 2; ++bj) *(u32x4*)(base + (size_t)(ai * 128 + m * 16) * D + bj * 128) = pack8(acc[ai][bj][m][0], acc[ai][bj][m][1]); }
        } else { bf16_t* base = lora + (size_t)rb * 256 + cb;
#pragma unroll
            for (int am_ = 0; am_ < 8; ++am_) { const int ai = am_ >> 2, m = am_ & 3;
#pragma unroll
                for (int bj = 0; bj < 2; ++bj) { f32x4 a = acc[ai][bj][m][0], b = acc[ai][bj][m][1]; const int cl = bj * 128 + cb;
#pragma unroll
                    for (int j = 0; j < 4; ++j) { a[j] = lora_act(a[j], cl); b[j] = lora_act(b[j], cl); }
                    *(u32x4*)(base + (size_t)(ai * 128 + m * 16) * 256 + bj * 128) = pack8(a, b); } }
        }
    }
};
__device__ __forceinline__ float wag_w(float v) { const float y = -v; const float sp = fmaxf(y, 0.f) + __logf(1.f + __expf(-fabsf(y))); return -__expf(-sp - 0.5f); }
struct EpiWag {
    static constexpr bool PERM = true, AFTER_DRAIN = false;
    const float* w0; const float* a0; float* ld; bf16_t* aa; bf16_t* gg;
    __device__ __forceinline__ void operator()(const f32x4 (&acc)[2][2][4][2], const pg8::Unit& u, int wr, int wc, int fr, int fq) const { asm volatile("" : "+v"(fr), "+v"(fq));
        const int t = u.pn >> 2; const int cb = (u.pn & 3) * 256 + wc * 32 + 8 * fq; const int rb = u.pm * 256 + wr * 64 + fr;
        if (t == 0) {
#pragma unroll
            for (int bj = 0; bj < 2; ++bj) { const int c = cb + bj * 128; const f32x4 b0 = *(const f32x4*)(w0 + c), b1 = *(const f32x4*)(w0 + c + 4);
#pragma unroll
                for (int am_ = 0; am_ < 8; ++am_) { const int ai = am_ >> 2, m = am_ & 3; const int row = rb + ai * 128 + m * 16; f32x4 a = acc[ai][bj][m][0], b = acc[ai][bj][m][1];
#pragma unroll
                    for (int j = 0; j < 4; ++j) { a[j] = wag_w(a[j] + b0[j]); b[j] = wag_w(b[j] + b1[j]); }
                    *(f32x4*)(ld + (size_t)row * D + c) = a; *(f32x4*)(ld + (size_t)row * D + c + 4) = b; } }
        } else if (t == 1) {
#pragma unroll
            for (int bj = 0; bj < 2; ++bj) { const int c = cb + bj * 128; const f32x4 b0 = *(const f32x4*)(a0 + c), b1 = *(const f32x4*)(a0 + c + 4);
#pragma unroll
                for (int am_ = 0; am_ < 8; ++am_) { const int ai = am_ >> 2, m = am_ & 3; const int row = rb + ai * 128 + m * 16; f32x4 a = acc[ai][bj][m][0], b = acc[ai][bj][m][1];
#pragma unroll
                    for (int j = 0; j < 4; ++j) { a[j] = sigmoidf_(a[j] + b0[j]); b[j] = sigmoidf_(b[j] + b1[j]); }
                    *(u32x4*)(aa + (size_t)row * D + c) = pack8(a, b); } }
        } else {
#pragma unroll
            for (int bj = 0; bj < 2; ++bj) { const int c = cb + bj * 128;
#pragma unroll
                for (int am_ = 0; am_ < 8; ++am_) { const int ai = am_ >> 2, m = am_ & 3; const int row = rb + ai * 128 + m * 16;
                    *(u32x4*)(gg + (size_t)row * D + c) = pack8(acc[ai][bj][m][0], acc[ai][bj][m][1]); } }
        }
    }
};
#define MFMA16(a, b, c) __builtin_amdgcn_mfma_f32_16x16x32_bf16((a), (b), (c), 0, 0, 0)
struct ALbf16 { const bf16_t* A; int lda;
    __device__ __forceinline__ bf16x8 load(int row, int k, float& sq) const { return *(const bf16x8*)(A + (size_t)row * lda + k); } };
struct ALx { const float* x;
    __device__ __forceinline__ bf16x8 load(int row, int k, float& sq) const { const f32x4 a = *(const f32x4*)(x + (size_t)row * D + k), b = *(const f32x4*)(x + (size_t)row * D + k + 4);
        sq += (a[0] * a[0] + a[1] * a[1]) + (a[2] * a[2] + a[3] * a[3]) + (b[0] * b[0] + b[1] * b[1]) + (b[2] * b[2] + b[3] * b[3]); return __builtin_bit_cast(bf16x8, pack8(a, b)); } };
template <int NB, class AL, class EP>
__device__ __forceinline__ void sgemm(int tid, int ntile, int ksplit, int Kc, const bf16_t* Bt, int ldb, const AL al, const EP ep) {
    const int lane = tid & 63, w = tid >> 6, fr = lane & 15, fq = lane >> 4, row = 16 * w + fr;
    for (int t = gridDim.x - 1 - blockIdx.x; t < ntile * ksplit; t += gridDim.x) {
        const int tn = t % ntile, ks = t / ntile, kb = ks * Kc + 8 * fq;
        f32x4 acc[NB]; const bf16_t* bp[NB];
#pragma unroll
        for (int nb = 0; nb < NB; ++nb) { acc[nb] = (f32x4){0.f, 0.f, 0.f, 0.f}; bp[nb] = Bt + (size_t)ep.brow(tn, nb, fr) * ldb + kb; }
        float sq = 0.f;
#pragma unroll 4
        for (int k = 0; k < Kc; k += 32) { const bf16x8 a = al.load(row, kb + k, sq);
#pragma unroll
            for (int nb = 0; nb < NB; ++nb) { const bf16x8 b = *(const bf16x8*)(bp[nb] + k); acc[nb] = MFMA16(b, a, acc[nb]); } }
        sq += __shfl_xor(sq, 16); sq += __shfl_xor(sq, 32);
        ep(tn, row, fq, acc, sq);
    }
}
struct SEpiSwiglu { bf16_t* act;
    __device__ __forceinline__ int brow(int tn, int nb, int i) const { const int a = 16 * tn + i; return 8 * (a >> 2) + 4 * nb + (a & 3); }
    __device__ __forceinline__ void operator()(int tn, int row, int fq, const f32x4 (&acc)[2], float sq) const { const float rstd = rsqrtf(sq * (1.f / D) + 1e-6f); f32x4 o;
#pragma unroll
        for (int j = 0; j < 4; ++j) { const float g = acc[0][j] * rstd; o[j] = g * sigmoidf_(g) * (acc[1][j] * rstd); }
        *(u32x2*)(act + (size_t)row * FF + 16 * tn + 4 * fq) = pack4(o); } };
__device__ __forceinline__ void sgemm_resid(int tid, LAS unsigned char* lds, const bf16_t* A, const bf16_t* Bt, int K, float* x, float scale) {
    const int lane = tid & 63, w = tid >> 6, fr = lane & 15, fq = lane >> 4, Kc = K >> 3, kb = w * Kc + 8 * fq;
    LAS f32x4* part = (LAS f32x4*)lds;
    for (int t = gridDim.x - 1 - blockIdx.x; t < 32; t += gridDim.x) {
        f32x4 acc[8][2];
#pragma unroll
        for (int rb = 0; rb < 8; ++rb) { acc[rb][0] = (f32x4){0.f, 0.f, 0.f, 0.f}; acc[rb][1] = (f32x4){0.f, 0.f, 0.f, 0.f}; }
        const bf16_t* bp0 = Bt + (size_t)(32 * t + fr) * K + kb; const bf16_t* bp1 = bp0 + (size_t)16 * K; const bf16_t* ap = A + (size_t)fr * K + kb;
        for (int k = 0; k < Kc; k += 32) { const bf16x8 b0 = *(const bf16x8*)(bp0 + k), b1 = *(const bf16x8*)(bp1 + k);
#pragma unroll
            for (int rb = 0; rb < 8; ++rb) { const bf16x8 av = *(const bf16x8*)(ap + (size_t)(16 * rb) * K + k); acc[rb][0] = MFMA16(b0, av, acc[rb][0]); acc[rb][1] = MFMA16(b1, av, acc[rb][1]); } }
#pragma unroll
        for (int rb = 0; rb < 8; ++rb) { part[(w * 16 + rb * 2) * 64 + lane] = acc[rb][0]; part[(w * 16 + rb * 2 + 1) * 64 + lane] = acc[rb][1]; }
        __syncthreads();
#pragma unroll
        for (int nb = 0; nb < 2; ++nb) { f32x4 s = part[(w * 2 + nb) * 64 + lane];
#pragma unroll
            for (int ww = 1; ww < 8; ++ww) s += part[(ww * 16 + w * 2 + nb) * 64 + lane];
            float* xp = x + (size_t)(16 * w + fr) * D + 32 * t + 16 * nb + 4 * fq; f32x4 xv = *(const f32x4*)xp; xv += s * scale; *(f32x4*)xp = xv; }
        __syncthreads();
    }
}
struct SEpiZ { bf16_t* z;
    __device__ __forceinline__ int brow(int tn, int nb, int i) const { return 32 * tn + 16 * nb + i; }
    __device__ __forceinline__ void operator()(int tn, int row, int fq, const f32x4 (&acc)[2], float sq) const { const float rstd = rsqrtf(sq * (1.f / D) + 1e-6f);
#pragma unroll
        for (int nb = 0; nb < 2; ++nb) *(u32x2*)(z + (size_t)row * NIN + 32 * tn + 16 * nb + 4 * fq) = pack4(acc[nb] * rstd); } };
struct SEpiRkvl { bf16_t* rkv; size_t stride; bf16_t* lora;
    __device__ __forceinline__ int brow(int tn, int nb, int i) const { return 32 * tn + 16 * nb + i; }
    __device__ __forceinline__ void operator()(int tn, int row, int fq, const f32x4 (&acc)[2], float sq) const {
#pragma unroll
        for (int nb = 0; nb < 2; ++nb) { const int c = 32 * tn + 16 * nb + 4 * fq;
            if (c < 3072) *(u32x2*)(rkv + (size_t)(c >> 10) * stride + (size_t)row * D + (c & 1023)) = pack4(acc[nb]);
            else { f32x4 a = acc[nb]; const int cl = c - 3072;
#pragma unroll
                for (int j = 0; j < 4; ++j) a[j] = lora_act(a[j], cl);
                *(u32x2*)(lora + (size_t)row * 256 + cl) = pack4(a); } } } };
struct SEpiWag { const float* w0; const float* a0; float* ld; bf16_t* aa; bf16_t* gg;
    __device__ __forceinline__ int brow(int tn, int nb, int i) const { return 32 * tn + 16 * nb + i; }
    __device__ __forceinline__ void operator()(int tn, int row, int fq, const f32x4 (&acc)[2], float sq) const {
#pragma unroll
        for (int nb = 0; nb < 2; ++nb) { const int cc = 32 * tn + 16 * nb + 4 * fq, t = cc >> 10, c = cc & 1023; f32x4 a = acc[nb];
            if (t == 0) { const f32x4 b0 = *(const f32x4*)(w0 + c);
#pragma unroll
                for (int j = 0; j < 4; ++j) a[j] = wag_w(a[j] + b0[j]);
                *(f32x4*)(ld + (size_t)row * D + c) = a; }
            else if (t == 1) { const f32x4 b0 = *(const f32x4*)(a0 + c);
#pragma unroll
                for (int j = 0; j < 4; ++j) a[j] = sigmoidf_(a[j] + b0[j]);
                *(u32x2*)(aa + (size_t)row * D + c) = pack4(a); }
            else *(u32x2*)(gg + (size_t)row * D + c) = pack4(a); } } };
struct TrSpec { const float* W; int K, N; const float* ks; int ksmode; bf16_t* WT; int ldT, kofs, rowmode, rowoff; };
__device__ __forceinline__ TrSpec make_spec(ArgsP a, int l, int si) {
    TrSpec s; const int i = l >> 1; bf16_t* W = (bf16_t*)(a->ws + WS_W);
    s.ks = nullptr; s.ksmode = 0; s.kofs = 0; s.rowmode = 0; s.rowoff = 0;
    if (si < 6) { const int j = si / 3, t = si % 3; const size_t lj = (size_t)(l * 2 + j);
        if (t < 2) { s.W = (t == 0 ? a->in[9] : a->in[10]) + lj * D * FF; s.K = D; s.N = FF; s.ks = a->in[8] + lj * D; s.ksmode = 1; s.WT = W + (j ? WE_GU1 : WE_GU0); s.ldT = D; s.rowmode = 1 + t; }
        else { s.W = a->in[11] + lj * FF * D; s.K = FF; s.N = D; s.WT = W + (j ? WE_DN1 : WE_DN0); s.ldT = FF; }
        return s; }
    if ((l & 1) == 0) {
        if (si == 6) { s.W = a->in[13] + (size_t)i * D * NIN; s.K = D; s.N = NIN; s.ks = a->in[12] + l * D; s.ksmode = 1; s.WT = W + WE_IN; s.ldT = D; }
        else if (si == 7) { s.W = a->in[17] + (size_t)i * D * D + 512 * D; s.K = 512; s.N = D; s.WT = W + WE_OUT; s.ldT = D; s.kofs = 512; }
        else { s.W = (const float*)(a->ws + WS_WEFF) + (size_t)i * 512 * D; s.K = 512; s.N = D; s.WT = W + WE_OUT; s.ldT = D; }
    } else {
        if (si == 18) { s.W = a->in[35] + (size_t)i * D * D; s.K = D; s.N = D; s.WT = W + WE_WO; s.ldT = D; }
        else { const int q = (si - 6) >> 1, hi = (si - 6) & 1;
            const int n = q < 3 ? 1024 : (q < 5 ? 64 : 128);
            const float* src = q == 0 ? a->in[19] : q == 1 ? a->in[20] : q == 2 ? a->in[21] : q == 3 ? a->in[23] : q == 4 ? a->in[26] : a->in[28];
            const int mui = q == 0 ? 0 : q == 1 ? 2 : q == 2 ? 3 : q == 3 ? 1 : q == 4 ? 4 : 5;
            s.W = src + (size_t)i * D * n; s.K = D; s.N = n; s.ks = a->in[18] + (size_t)(i * 6 + mui) * D; s.ksmode = hi ? 1 : 2; s.WT = W + WE_RKVL; s.ldT = 2048; s.kofs = hi ? 1024 : 0;
            s.rowoff = q < 3 ? 1024 * q : (q == 3 ? 3072 : (q == 4 ? 3136 : 3200)); }
    }
    return s;
}
__device__ __forceinline__ void tr_item(const TrSpec& s, LAS float* scr, int item, int lane) {
    const int nblk = s.N / 32, kb = item / nblk, nb = item % nblk, k0 = 64 * kb, n0 = 32 * nb;
#pragma unroll 8
    for (int i = 0; i < 32; ++i) { const int kk = 2 * i + (lane >> 5); float v = s.W[(size_t)(k0 + kk) * s.N + n0 + (lane & 31)];
        if (s.ksmode) { const float m = s.ks[k0 + kk]; v *= (s.ksmode == 1 ? m : 1.f - m); }
        scr[kk * 33 + (lane & 31)] = v; }
    asm volatile("s_waitcnt lgkmcnt(0)" ::: "memory");
    const int c = lane & 7;
#pragma unroll
    for (int j = 0; j < 4; ++j) { const int n = (lane >> 3) + 8 * j; const LAS float* p = scr + (8 * c) * 33 + n; const int gn = n0 + n;
        const int drow = s.rowmode == 0 ? s.rowoff + gn : (8 * (gn >> 2) + (gn & 3) + (s.rowmode == 2 ? 4 : 0));
        u32x4 o; o.x = pk2(p[0 * 33], p[1 * 33]); o.y = pk2(p[2 * 33], p[3 * 33]); o.z = pk2(p[4 * 33], p[5 * 33]); o.w = pk2(p[6 * 33], p[7 * 33]);
        *(u32x4*)(s.WT + (size_t)drow * s.ldT + s.kofs + k0 + 8 * c) = o; }
    asm volatile("s_waitcnt lgkmcnt(0)" ::: "memory");
}
__device__ __forceinline__ void convert_layer(ArgsP a, int l, LAS unsigned char* lds, const int tid) {
    const int lane = tid & 63, wave = tid >> 6, gw = blockIdx.x * 8 + wave, NGW = gridDim.x * 8;
    LAS float* scr = (LAS float*)(lds + wave * 16384);
    const int nspec = (l & 1) ? 19 : 9;
    int base = 0;
    for (int si = 0; si < nspec; ++si) { const TrSpec s = make_spec(a, l, si); const int items = (s.K / 64) * (s.N / 32);
        int first = gw - (base % NGW); if (first < 0) first += NGW;
        for (int it = first; it < items; it += NGW) tr_item(s, scr, it, lane);
        base += items; }
    if (l & 1) { const int i = l >> 1; bf16_t* WT = (bf16_t*)(a->ws + WS_W) + WE_WAG;
        for (int q = blockIdx.x * 512 + tid; q < NWAG * 32; q += gridDim.x * 512) { const int n = q % NWAG, k0 = (q / NWAG) * 8, t = n >> 10, c = n & 1023;
            const float* src = nullptr; int kb = 0;
            if (t == 0 && k0 < 64) { src = a->in[24] + (size_t)i * 64 * D; kb = k0; } else if (t == 1 && k0 >= 64 && k0 < 128) { src = a->in[27] + (size_t)i * 64 * D; kb = k0 - 64; } else if (t == 2 && k0 >= 128) { src = a->in[29] + (size_t)i * 128 * D; kb = k0 - 128; }
            u32x4 o = {0u, 0u, 0u, 0u};
            if (src) { float v[8];
#pragma unroll
                for (int e = 0; e < 8; ++e) v[e] = src[(size_t)(kb + e) * D + c];
                o.x = pk2(v[0], v[1]); o.y = pk2(v[2], v[3]); o.z = pk2(v[4], v[5]); o.w = pk2(v[6], v[7]); }
            *(u32x4*)(WT + (size_t)n * 256 + k0) = o; } }
}
__device__ __forceinline__ void phase_init(ArgsP a, const int tid) {
    const int lane = tid & 63, gw = blockIdx.x * 8 + (tid >> 6), NGW = gridDim.x * 8;
    float* x = a->out; bf16_t* xb = (bf16_t*)(a->ws + WS_XB); float* ss = (float*)(a->ws + WS_SS);
    for (int m = gw; m < MT; m += NGW) { const float* src = m < MP ? a->in[0] + (size_t)m * D : a->in[1] + (size_t)(m - MP) * D; float s = 0.f; f32x4 v[4];
#pragma unroll
        for (int j = 0; j < 4; ++j) { v[j] = *(const f32x4*)(src + 4 * lane + 256 * j); *(f32x4*)(x + (size_t)m * D + 4 * lane + 256 * j) = v[j]; s += (v[j][0] * v[j][0] + v[j][1] * v[j][1]) + (v[j][2] * v[j][2] + v[j][3] * v[j][3]); }
        if (m < MP) { s = wave_sum(s); if (lane < 16) ss[(size_t)m * 16 + lane] = lane == 0 ? s : 0.f;
#pragma unroll
            for (int j = 0; j < 4; ++j) *(u32x2*)(xb + (size_t)m * D + 4 * lane + 256 * j) = pack4(v[j]); } }
    const int gt = blockIdx.x * 512 + tid, NT = gridDim.x * 512;
    float* weff = (float*)(a->ws + WS_WEFF);
    for (int q = gt; q < 2 * 512 * D; q += NT) { const int i = q >> 19, k = (q >> 10) & 511, n = q & 1023, g = k >> 7;
        const float* pw = a->in[14] + ((size_t)(i * 4 + g) * 128 + (k & 127)) * 128; const float* ps = a->in[15] + i * 512 + g * 128; const float* wo = a->in[17] + (size_t)i * D * D + (size_t)(g * 128) * D + n;
        float acc = 0.f;
        for (int d = 0; d < 128; ++d) acc += pw[d] * ps[d] * wo[(size_t)d * D];
        weff[q] = acc; }
}
__device__ __forceinline__ void phase_final(ArgsP a, const int tid) {
    const int lane = tid & 63, gw = blockIdx.x * 8 + (tid >> 6), NGW = gridDim.x * 8; float* x = a->out; const float* gn = a->in[36];
    for (int m = gw; m < MT; m += NGW) { float s = 0.f; f32x4 v[4];
#pragma unroll
        for (int j = 0; j < 4; ++j) { v[j] = *(const f32x4*)(x + (size_t)m * D + 4 * lane + 256 * j); s += (v[j][0] * v[j][0] + v[j][1] * v[j][1]) + (v[j][2] * v[j][2] + v[j][3] * v[j][3]); }
        const float rstd = rsqrtf(wave_sum(s) * (1.f / D) + 1e-6f);
#pragma unroll
        for (int j = 0; j < 4; ++j) { const f32x4 g = *(const f32x4*)(gn + 4 * lane + 256 * j); *(f32x4*)(x + (size_t)m * D + 4 * lane + 256 * j) = v[j] * rstd * g; } }
}
__device__ __forceinline__ void phase_shift(ArgsP a, int l, const int tid) {
    const int i = l >> 1, lane = tid & 63, gw = blockIdx.x * 8 + (tid >> 6), NGW = gridDim.x * 8;
    const float* x = a->out; const float* gn = a->in[12] + l * D; bf16_t* hh = (bf16_t*)(a->ws + WS_HH);
    for (int m = gw; m < MT; m += NGW) { int b, t; const bool smp = m >= MP; if (!smp) { b = m >> 12; t = m & 4095; } else { b = (m - MP) >> 4; t = (m - MP) & 15; }
        f32x4 v[4], p[4]; float s = 0.f, sp = 0.f;
#pragma unroll
        for (int j = 0; j < 4; ++j) { v[j] = *(const f32x4*)(x + (size_t)m * D + 4 * lane + 256 * j); s += (v[j][0] * v[j][0] + v[j][1] * v[j][1]) + (v[j][2] * v[j][2] + v[j][3] * v[j][3]); }
        if (t > 0) {
#pragma unroll
            for (int j = 0; j < 4; ++j) { p[j] = *(const f32x4*)(x + (size_t)(m - 1) * D + 4 * lane + 256 * j); sp += (p[j][0] * p[j][0] + p[j][1] * p[j][1]) + (p[j][2] * p[j][2] + p[j][3] * p[j][3]); } }
        const float rstd = rsqrtf(wave_sum(s) * (1.f / D) + 1e-6f), rstdp = rsqrtf(wave_sum(sp) * (1.f / D) + 1e-6f);
#pragma unroll
        for (int j = 0; j < 4; ++j) { const int c = 4 * lane + 256 * j; const f32x4 g = *(const f32x4*)(gn + c); const f32x4 h = v[j] * rstd * g; f32x4 hp;
            if (t > 0) hp = p[j] * rstdp * g; else if (smp) hp = *(const f32x4*)(a->in[5] + (size_t)(i * NB_S + b) * D + c); else hp = (f32x4){0.f, 0.f, 0.f, 0.f};
            *(u32x2*)(hh + (size_t)m * 2048 + c) = pack4(h); *(u32x2*)(hh + (size_t)m * 2048 + 1024 + c) = pack4(hp);
            if (!smp && t == SEQ - 1) *(f32x4*)(a->out + O_SHP + (size_t)(i * NB_P + b) * D + c) = h;
            if (smp && t == LS - 1) *(f32x4*)(a->out + O_SHS + (size_t)(i * NB_S + b) * D + c) = h; } }
}
#define MFMA32(a, b, c) __builtin_amdgcn_mfma_f32_32x32x16_bf16((a), (b), (c), 0, 0, 0)
__device__ __forceinline__ int t5_bucket(int rel) { const int n = rel < 0 ? -rel : rel; const int side = rel > 0 ? 16 : 0;
    const int b = n < 8 ? n : n < 12 ? 8 : n < 16 ? 9 : n < 23 ? 10 : n < 32 ? 11 : n < 46 ? 12 : n < 64 ? 13 : n < 91 ? 14 : 15; return side + b; }
__device__ __forceinline__ void phase_attn(ArgsP a, int i, LAS unsigned char* lds, const int tid) {
    const bf16_t* z = (const bf16_t*)(a->ws + WS_Z); bf16_t* cat = (bf16_t*)(a->ws + WS_CAT);
    LAS bf16_t* Kl = (LAS bf16_t*)lds;
    LAS bf16_t* Vt = (LAS bf16_t*)(lds + 27648);
    LAS float* bl = (LAS float*)(lds + 27648 + 25600);
    const int lane = tid & 63, w = tid >> 6, r = lane & 31, h = lane >> 5;
    const float* t5 = a->in[7];
    for (int u = blockIdx.x; u < 512 + 16; u += gridDim.x) {
        const bool smp = u >= 512; int b, c, hk;
        if (!smp) { hk = u & 1; c = (u >> 1) & 63; b = u >> 7; } else { hk = (u - 512) & 1; b = (u - 512) >> 1; c = 2; }
        for (int q = tid; q < 192 * 8; q += 512) { const int j = q >> 3, ch = q & 7; u32x4 kv = {0u, 0u, 0u, 0u}, vv = {0u, 0u, 0u, 0u};
            if (!smp) { const int t = 64 * (c - 2) + j; if (t >= 0) { const bf16_t* p = z + (size_t)(b * SEQ + t) * NIN + 1024 + hk * 64 + ch * 8; kv = *(const u32x4*)p; vv = *(const u32x4*)(p + 128); } }
            else if (j < 128) { const size_t o = ((size_t)((i * NB_S + b) * 128 + j) * 2 + hk) * 64 + ch * 8;
                kv = pack8(*(const f32x4*)(a->in[3] + o), *(const f32x4*)(a->in[3] + o + 4)); vv = pack8(*(const f32x4*)(a->in[4] + o), *(const f32x4*)(a->in[4] + o + 4)); }
            else if (j < 144) { const bf16_t* p = z + (size_t)(MP + b * LS + (j - 128)) * NIN + 1024 + hk * 64 + ch * 8; kv = *(const u32x4*)p; vv = *(const u32x4*)(p + 128); }
            *(LAS u32x4*)(Kl + j * 72 + ch * 8) = kv;
            LAS bf16_t* vp = Vt + (ch * 8) * 200 + j;
            vp[0] = (bf16_t)(vv.x & 0xffffu); vp[200] = (bf16_t)(vv.x >> 16); vp[400] = (bf16_t)(vv.y & 0xffffu); vp[600] = (bf16_t)(vv.y >> 16);
            vp[800] = (bf16_t)(vv.z & 0xffffu); vp[1000] = (bf16_t)(vv.z >> 16); vp[1200] = (bf16_t)(vv.w & 0xffffu); vp[1400] = (bf16_t)(vv.w >> 16); }
        for (int q = tid; q < 1024; q += 512) { const int g = q >> 8, ri = q & 255; bl[q] = ri < 255 ? t5[t5_bucket(ri - 191) * 8 + hk * 4 + g] : 0.f; }
        __syncthreads();
        if (!smp || w < 2) {
            int g, iq, qrow; if (!smp) { g = w >> 1; iq = 32 * (w & 1) + r; qrow = b * SEQ + 64 * c + iq; } else { g = 2 * w + (r >> 4); iq = r & 15; qrow = MP + b * LS + iq; }
            const int head = hk * 4 + g; const float sink = a->in[16][i * 8 + head];
            bf16x8 qf[4];
#pragma unroll
            for (int s = 0; s < 4; ++s) qf[s] = *(const bf16x8*)(z + (size_t)qrow * NIN + 512 + head * 64 + 16 * s + 8 * h);
            f32x16 st[6];
#pragma unroll
            for (int kb = 0; kb < 6; ++kb) {
#pragma unroll
                for (int e = 0; e < 16; ++e) st[kb][e] = 0.f;
#pragma unroll
                for (int s = 0; s < 4; ++s) { const bf16x8 kf = *(const LAS bf16x8*)(Kl + (32 * kb + r) * 72 + 16 * s + 8 * h); st[kb] = MFMA32(kf, qf[s], st[kb]); } }
            const int kmin = smp ? 0 : (c >= 2 ? 0 : 128 - 64 * c), kmax = smp ? 144 : 192;
            float mx = sink; const LAS float* blp = bl + g * 256 - iq + 63;
#pragma unroll
            for (int kb = 0; kb < 6; ++kb)
#pragma unroll
                for (int e = 0; e < 16; ++e) { const int key = 32 * kb + (e & 3) + 8 * (e >> 2) + 4 * h; float s = st[kb][e] * 0.125f + blp[key]; if (key < kmin || key >= kmax) s = -1e30f; st[kb][e] = s; mx = fmaxf(mx, s); }
            mx = fmaxf(mx, __shfl_xor(mx, 32));
            float sum = 0.f;
#pragma unroll
            for (int kb = 0; kb < 6; ++kb)
#pragma unroll
                for (int e = 0; e < 16; ++e) { const float p = __expf(st[kb][e] - mx); st[kb][e] = p; sum += p; }
            sum += __shfl_xor(sum, 32); const float inv = 1.f / (sum + __expf(sink - mx));
            f32x16 o[2];
#pragma unroll
            for (int e = 0; e < 16; ++e) { o[0][e] = 0.f; o[1][e] = 0.f; }
#pragma unroll
            for (int kb = 0; kb < 6; ++kb)
#pragma unroll
                for (int s2 = 0; s2 < 2; ++s2) { u32x4 pw; pw.x = pk2(st[kb][8 * s2], st[kb][8 * s2 + 1]); pw.y = pk2(st[kb][8 * s2 + 2], st[kb][8 * s2 + 3]); pw.z = pk2(st[kb][8 * s2 + 4], st[kb][8 * s2 + 5]); pw.w = pk2(st[kb][8 * s2 + 6], st[kb][8 * s2 + 7]);
                    const bf16x8 pf = __builtin_bit_cast(bf16x8, pw);
#pragma unroll
                    for (int db = 0; db < 2; ++db) { const LAS bf16_t* vp = Vt + (32 * db + r) * 200 + 32 * kb + 16 * s2 + 4 * h; const u32x2 lo = *(const LAS u32x2*)vp, hi = *(const LAS u32x2*)(vp + 8);
                        u32x4 vw; vw.x = lo.x; vw.y = lo.y; vw.z = hi.x; vw.w = hi.y; o[db] = MFMA32(__builtin_bit_cast(bf16x8, vw), pf, o[db]); } }
#pragma unroll
            for (int db = 0; db < 2; ++db)
#pragma unroll
                for (int rg = 0; rg < 4; ++rg) { const int d0 = 32 * db + 8 * rg + 4 * h; f32x4 v = {o[db][4 * rg] * inv, o[db][4 * rg + 1] * inv, o[db][4 * rg + 2] * inv, o[db][4 * rg + 3] * inv};
                    *(u32x2*)(cat + (size_t)qrow * D + 512 + head * 64 + d0) = pack4(v); }
        }
        __syncthreads();
    }
    const int gt = blockIdx.x * 512 + tid, NT = gridDim.x * 512;
    for (int q = gt; q < MT * 64; q += NT) { const int m = q >> 6, c0 = (q & 63) * 8, wdw = 2 << (c0 >> 7); const bool smp = m >= MP; int b, t; if (!smp) { b = m >> 12; t = m & 4095; } else { b = (m - MP) >> 4; t = (m - MP) & 15; }
        float s[8], cur[8];
#pragma unroll
        for (int e = 0; e < 8; ++e) { s[e] = 0.f; cur[e] = 0.f; }
        for (int d = 0; d < wdw; ++d) { const int ts = t - d; float v[8];
            if (ts >= 0) { const u32x4 zz = *(const u32x4*)(z + (size_t)(m - d) * NIN + c0); v[0] = bflo(zz.x); v[1] = bfhi(zz.x); v[2] = bflo(zz.y); v[3] = bfhi(zz.y); v[4] = bflo(zz.z); v[5] = bfhi(zz.z); v[6] = bflo(zz.w); v[7] = bfhi(zz.w); }
            else if (smp) { const float* hp = a->in[2] + ((size_t)(i * NB_S + b) * 15 + 15 + ts) * 512 + c0; const f32x4 h0 = *(const f32x4*)hp, h1 = *(const f32x4*)(hp + 4); v[0] = h0[0]; v[1] = h0[1]; v[2] = h0[2]; v[3] = h0[3]; v[4] = h1[0]; v[5] = h1[1]; v[6] = h1[2]; v[7] = h1[3]; }
            else {
#pragma unroll
                for (int e = 0; e < 8; ++e) v[e] = 0.f; }
#pragma unroll
            for (int e = 0; e < 8; ++e) { s[e] += v[e]; if (d == 0) cur[e] = v[e]; } }
        const float rc = 1.f / (float)(smp ? wdw : (wdw < t + 1 ? wdw : t + 1));
        f32x4 o0, o1;
#pragma unroll
        for (int e = 0; e < 4; ++e) { o0[e] = s[e] * rc - cur[e]; o1[e] = s[4 + e] * rc - cur[4 + e]; }
        *(u32x4*)(cat + (size_t)m * D + c0) = pack8(o0, o1); }
    for (int q = gt; q < NB_P * 15 * 512; q += NT) { const int c = q & 511, rr = (q >> 9) % 15, b = q / (15 * 512); a->out[O_POOLP + (size_t)i * NB_P * 15 * 512 + q] = bflo((unsigned)z[(size_t)(b * SEQ + SEQ - 15 + rr) * NIN + c]); }
    for (int q = gt; q < NB_S * 15 * 512; q += NT) { const int c = q & 511, rr = (q >> 9) % 15, b = q / (15 * 512); a->out[O_POOLS + (size_t)i * NB_S * 15 * 512 + q] = bflo((unsigned)z[(size_t)(MP + b * LS + 1 + rr) * NIN + c]); }
    for (int q = gt; q < NB_P * 128 * 128; q += NT) { const int cd = q & 127, rr = (q >> 7) & 127, b = q >> 14; const bf16_t* p = z + (size_t)(b * SEQ + SEQ - 128 + rr) * NIN + 1024 + cd;
        a->out[O_KP + (size_t)i * NB_P * 16384 + q] = bflo((unsigned)p[0]); a->out[O_VP + (size_t)i * NB_P * 16384 + q] = bflo((unsigned)p[128]); }
    for (int q = gt; q < NB_S * 128 * 128; q += NT) { const int cd = q & 127, rr = (q >> 7) & 127, b = q >> 14; float kv, vv;
        if (rr < 112) { const size_t o = ((size_t)(i * NB_S + b) * 128 + rr + 16) * 128 + cd; kv = a->in[3][o]; vv = a->in[4][o]; }
        else { const bf16_t* p = z + (size_t)(MP + b * LS + rr - 112) * NIN + 1024 + cd; kv = bflo((unsigned)p[0]); vv = bflo((unsigned)p[128]); }
        a->out[O_KS + (size_t)i * NB_S * 16384 + q] = kv; a->out[O_VS + (size_t)i * NB_S * 16384 + q] = vv; }
}
constexpr int SC_BUF = 49152, SC_YB = 2 * SC_BUF, SC_ARR = 2048;
struct ScanRaw { u32x4 r2, k2, v2, a2; f32x4 l0, l1; };
__device__ __forceinline__ void scan_load(ArgsP a, ScanRaw& R, int pt, int m0, int T, int hd) {
    const int ts = pt >> 3, c8 = (pt & 7) * 8;
    if (ts < T) { const size_t m = (size_t)(m0 + ts); const int hc = hd * 64 + c8; unsigned char* ws = a->ws;
        R.r2 = *(const u32x4*)((const bf16_t*)(ws + WS_R) + m * D + hc); R.k2 = *(const u32x4*)((const bf16_t*)(ws + WS_K) + m * D + hc); R.v2 = *(const u32x4*)((const bf16_t*)(ws + WS_V) + m * D + hc); R.a2 = *(const u32x4*)((const bf16_t*)(ws + WS_AA) + m * D + hc);
        R.l0 = *(const f32x4*)((const float*)(ws + WS_LD) + m * D + hc); R.l1 = *(const f32x4*)((const float*)(ws + WS_LD) + m * D + hc + 4); }
}
__device__ __forceinline__ void scan_prep(ArgsP a, const ScanRaw& R, LAS float* buf, int pt, int m0, int T, int hd, int rq, const f32x4 (&kk8)[2], const f32x4 (&ka8)[2], const f32x4 (&rk8)[2]) {
    const int ts = pt >> 3, c8 = (pt & 7) * 8;
    if (ts < T) { const size_t m = (size_t)(m0 + ts); unsigned char* ws = a->ws;
        const u32x4 r2 = R.r2, k2 = R.k2, v2 = R.v2, a2 = R.a2; const f32x4 l0 = R.l0, l1 = R.l1;
        const f32x4 r0 = {bflo(r2.x), bfhi(r2.x), bflo(r2.y), bfhi(r2.y)}, r1 = {bflo(r2.z), bfhi(r2.z), bflo(r2.w), bfhi(r2.w)};
        const f32x4 k0 = {bflo(k2.x), bfhi(k2.x), bflo(k2.y), bfhi(k2.y)}, k1 = {bflo(k2.z), bfhi(k2.z), bflo(k2.w), bfhi(k2.w)};
        const f32x4 v0 = {bflo(v2.x), bfhi(v2.x), bflo(v2.y), bfhi(v2.y)}, v1 = {bflo(v2.z), bfhi(v2.z), bflo(v2.w), bfhi(v2.w)};
        const f32x4 a0 = {bflo(a2.x), bfhi(a2.x), bflo(a2.y), bfhi(a2.y)}, a1 = {bflo(a2.z), bfhi(a2.z), bflo(a2.w), bfhi(a2.w)};
        f32x4 q0 = k0 * kk8[0], q1 = k1 * kk8[1];
        float ssq = ((q0[0] * q0[0] + q0[1] * q0[1]) + (q0[2] * q0[2] + q0[3] * q0[3])) + ((q1[0] * q1[0] + q1[1] * q1[1]) + (q1[2] * q1[2] + q1[3] * q1[3])); ssq = red8(ssq);
        const float inv = rsqrtf(fmaxf(ssq, 1e-24f)); q0 = q0 * inv; q1 = q1 * inv;
        const f32x4 p0 = k0 * (1.f + (a0 - 1.f) * ka8[0]), p1 = k1 * (1.f + (a1 - 1.f) * ka8[1]); f32x4 d0, d1;
#pragma unroll
        for (int e = 0; e < 4; ++e) { d0[e] = __expf(l0[e]); d1[e] = __expf(l1[e]); }
        const f32x4 t0 = r0 * p0 * rk8[0], t1 = r1 * p1 * rk8[1]; float bo = ((t0[0] + t0[1]) + (t0[2] + t0[3])) + ((t1[0] + t1[1]) + (t1[2] + t1[3])); bo = red8(bo);
        LAS float* o = buf + ts * 64 + c8;
        *(LAS f32x4*)(o) = -q0; *(LAS f32x4*)(o + 4) = -q1; *(LAS f32x4*)(o + SC_ARR) = d0; *(LAS f32x4*)(o + SC_ARR + 4) = d1; *(LAS f32x4*)(o + 2 * SC_ARR) = q0 * a0; *(LAS f32x4*)(o + 2 * SC_ARR + 4) = q1 * a1;
        *(LAS f32x4*)(o + 3 * SC_ARR) = p0; *(LAS f32x4*)(o + 3 * SC_ARR + 4) = p1; *(LAS f32x4*)(o + 4 * SC_ARR) = r0; *(LAS f32x4*)(o + 4 * SC_ARR + 4) = r1; *(LAS f32x4*)(o + 5 * SC_ARR) = v0; *(LAS f32x4*)(o + 5 * SC_ARR + 4) = v1;
        if (rq == 0 && (pt & 7) == 0) ((float*)(ws + WS_LORA))[m * 16 + hd] = bo; }
}
#define SCAN_BAR() asm volatile("s_waitcnt lgkmcnt(0)\n\ts_barrier" ::: "memory")
__device__ __forceinline__ void phase_scan(ArgsP a, int l, LAS unsigned char* lds, const int tid) {
    const int i = l >> 1, lane = tid & 63, w = tid >> 6, pt = tid - 256;
    const int rl = lane >> 4, cq = lane & 15, rloc = 4 * (w & 3) + rl;
    LAS float* ybuf = (LAS float*)(lds + SC_YB);
    for (int task = blockIdx.x; task < 256 + 512; task += gridDim.x) {
        const bool smp = task >= 256; const int tk = smp ? task - 256 : task, sq = tk >> 2, rq = tk & 3, b = sq >> 4, hd = sq & 15;
        const int L = smp ? LS : SEQ, row0 = smp ? MP + b * LS : b * SEQ, nch = (L + 31) >> 5, srow = 16 * rq + rloc;
        f32x4 S = {0.f, 0.f, 0.f, 0.f};
        if (smp && w < 4) S = *(const f32x4*)(a->in[6] + ((size_t)((i * NB_S + b) * 16 + hd) * 64 + srow) * 64 + 4 * cq);
        f32x4 kk8[2], ka8[2], rk8[2];
        { const int hc = hd * 64 + ((pt & 7) * 8 & 63); kk8[0] = *(const f32x4*)(a->in[30] + i * D + hc); kk8[1] = *(const f32x4*)(a->in[30] + i * D + hc + 4); ka8[0] = *(const f32x4*)(a->in[31] + i * D + hc); ka8[1] = *(const f32x4*)(a->in[31] + i * D + hc + 4);
          rk8[0] = *(const f32x4*)(a->in[32] + i * D + hc); rk8[1] = *(const f32x4*)(a->in[32] + i * D + hc + 4); }
        bf16_t* Y = (bf16_t*)(a->ws + WS_XB);
        ScanRaw R;
        if (w >= 4) { scan_load(a, R, pt, row0, L < 32 ? L : 32, hd); scan_prep(a, R, (LAS float*)lds, pt, row0, L < 32 ? L : 32, hd, rq, kk8, ka8, rk8); if (nch > 1) scan_load(a, R, pt, row0 + 32, 32, hd); }
        SCAN_BAR();
        for (int c = 0; c < nch; ++c) { const int T = (L - 32 * c) < 32 ? (L - 32 * c) : 32;
            if (w < 4) { const LAS float* bp = (const LAS float*)(lds + (c & 1) * SC_BUF) + 4 * cq; const LAS float* vp = (const LAS float*)(lds + (c & 1) * SC_BUF) + 5 * SC_ARR + srow; LAS float* yb = ybuf + (c & 1) * 512 + rloc;
                f32x4 n4 = *(const LAS f32x4*)bp, d4 = *(const LAS f32x4*)(bp + SC_ARR), b4 = *(const LAS f32x4*)(bp + 2 * SC_ARR), p4 = *(const LAS f32x4*)(bp + 3 * SC_ARR), r4 = *(const LAS f32x4*)(bp + 4 * SC_ARR); float vi = vp[0];
                f32x4 rp = {0.f, 0.f, 0.f, 0.f};
                for (int ts = 0; ts < T; ++ts) { const int tn = ts + 1 < 32 ? ts + 1 : 31; const LAS float* p = bp + tn * 64;
                    const f32x4 nn = *(const LAS f32x4*)p, dn = *(const LAS f32x4*)(p + SC_ARR), bn = *(const LAS f32x4*)(p + 2 * SC_ARR), pn = *(const LAS f32x4*)(p + 3 * SC_ARR), rn = *(const LAS f32x4*)(p + 4 * SC_ARR); const float vn = vp[tn * 64];
                    float sa = (S[0] * n4[0] + S[1] * n4[1]) + (S[2] * n4[2] + S[3] * n4[3]);
                    float yp = (S[0] * rp[0] + S[1] * rp[1]) + (S[2] * rp[2] + S[3] * rp[3]);
                    const f32x4 tmp = S * d4 + p4 * vi;
                    sa += dpp_f<0xB1>(sa); yp += dpp_f<0xB1>(yp); sa += dpp_f<0x4E>(sa); yp += dpp_f<0x4E>(yp); sa += dpp_f<0x141>(sa); yp += dpp_f<0x141>(yp); sa += dpp_f<0x140>(sa); yp += dpp_f<0x140>(yp);
                    S = tmp + b4 * sa;
                    if (cq == 0) yb[ts > 0 ? (ts - 1) * 16 : 1024] = yp;
                    n4 = nn; d4 = dn; b4 = bn; p4 = pn; rp = r4; r4 = rn; vi = vn; }
                { float yp = (S[0] * rp[0] + S[1] * rp[1]) + (S[2] * rp[2] + S[3] * rp[3]); yp = red16(yp); if (cq == 0) yb[(T - 1) * 16] = yp; }
            } else {
                if (c + 1 < nch) scan_prep(a, R, (LAS float*)(lds + ((c + 1) & 1) * SC_BUF), pt, row0 + 32 * (c + 1), 32, hd, rq, kk8, ka8, rk8);
                if (c + 2 < nch) scan_load(a, R, pt, row0 + 32 * (c + 2), 32, hd);
                if (c > 0) { const int ts = pt >> 3, r2 = (pt & 7) * 2; const LAS float* yp = ybuf + ((c - 1) & 1) * 512 + ts * 16 + r2;
                    *(unsigned*)(Y + (size_t)(row0 + 32 * (c - 1) + ts) * D + hd * 64 + 16 * rq + r2) = pk2(yp[0], yp[1]); }
            }
            SCAN_BAR();
        }
        if (w >= 4) { const int c = nch - 1, T = (L - 32 * c) < 32 ? (L - 32 * c) : 32, ts = pt >> 3, r2 = (pt & 7) * 2; const LAS float* yp = ybuf + (c & 1) * 512 + ts * 16 + r2;
            if (ts < T) *(unsigned*)(Y + (size_t)(row0 + 32 * c + ts) * D + hd * 64 + 16 * rq + r2) = pk2(yp[0], yp[1]); }
        else { float* so = a->out + (smp ? O_WKVS + (size_t)((i * NB_S + b) * 16 + hd) * 4096 : O_WKVP + (size_t)((i * NB_P + b) * 16 + hd) * 4096) + srow * 64 + 4 * cq; *(f32x4*)so = S; }
        __syncthreads();
    }
}
__device__ __forceinline__ void phase_post(ArgsP a, int l, const int tid) {
    const int i = l >> 1; unsigned char* ws = a->ws; const bf16_t* Y = (const bf16_t*)(ws + WS_XB); const bf16_t* Vb = (const bf16_t*)(ws + WS_V); const bf16_t* GG = (const bf16_t*)(ws + WS_G); const float* BO = (const float*)(ws + WS_LORA); bf16_t* AWO = (bf16_t*)(ws + WS_AWO);
    const float* lw = a->in[33] + i * D; const float* lb = a->in[34] + i * D;
    for (int q = blockIdx.x * 512 + tid; q < MT * 256; q += gridDim.x * 512) { const size_t m = (size_t)(q >> 8); const int c = (q & 255) * 4;
        const u32x2 y2 = *(const u32x2*)(Y + m * D + c), v2 = *(const u32x2*)(Vb + m * D + c), g2 = *(const u32x2*)(GG + m * D + c); const float bo = BO[m * 16 + (c >> 6)];
        const f32x4 y4 = {bflo(y2.x), bfhi(y2.x), bflo(y2.y), bfhi(y2.y)}, v4 = {bflo(v2.x), bfhi(v2.x), bflo(v2.y), bfhi(v2.y)}, g4 = {bflo(g2.x), bfhi(g2.x), bflo(g2.y), bfhi(g2.y)};
        const float mean = red16((y4[0] + y4[1]) + (y4[2] + y4[3])) * (1.f / 64.f); const f32x4 dv = y4 - mean;
        const float var = red16((dv[0] * dv[0] + dv[1] * dv[1]) + (dv[2] * dv[2] + dv[3] * dv[3])) * (1.f / 64.f); const float rs = rsqrtf(var + 64e-5f);
        const f32x4 yn = dv * rs * *(const f32x4*)(lw + c) + *(const f32x4*)(lb + c);
        *(u32x2*)(AWO + m * D + c) = pack4((yn + v4 * bo) * g4); }
}
#define GAS __attribute__((address_space(1)))
#define XB_TMO      128
#define XB_XCNT(j)  (256  + 64 * (j))
#define XB_XSUB(j)  (1280 + 64 * (j))
#define XB_XGEN(j)  (2304 + 64 * (j))
#define XB_TOP      3328
#define XB_TOPGEN   3392
#define XCD_BAR_WORDS 3456
#define XB_SPIN_CAP (1u << 18)

__device__ __forceinline__ unsigned xb_ld(unsigned* p)              { return __hip_atomic_load(p, __ATOMIC_RELAXED, __HIP_MEMORY_SCOPE_AGENT); }
__device__ __forceinline__ unsigned xb_add(unsigned* p, unsigned v) { return __hip_atomic_fetch_add(p, v, __ATOMIC_RELAXED, __HIP_MEMORY_SCOPE_AGENT); }
__device__ __forceinline__ unsigned xb_xcc_id() { return (unsigned)__builtin_amdgcn_s_getreg((3 << 11) | 20) & 0xFu; }
#define XB_SPIN(cond, bar) do { unsigned _sp = 0; while (cond) { __builtin_amdgcn_s_sleep(1); \
    if ((++_sp & 255u) == 0u) { if (xb_ld(&(bar)[XB_TMO])) break; if (_sp > XB_SPIN_CAP) { atomicAdd(&(bar)[XB_TMO], 1u); break; } } } } while (0)

struct XcdBarrier {
    unsigned* bar; unsigned x;
    volatile LAS unsigned* st;
};

__device__ __forceinline__ XcdBarrier xcd_barrier_post(unsigned* bar, volatile LAS unsigned* st) {
    XcdBarrier b; b.bar = bar; b.x = xb_xcc_id(); b.st = st;
    if (threadIdx.x == 0) (void)xb_add(&bar[XB_XCNT(b.x)], 1u);
    return b;
}
__device__ __forceinline__ void xcd_barrier_complete(unsigned* bar, unsigned x, unsigned& nloc, unsigned& nx) {
    const unsigned G = gridDim.x * gridDim.y * gridDim.z;
    unsigned sum, cnt, mine, sp = 0u;
    for (;;) {
        sum = 0u; cnt = 0u; mine = 0u;
#pragma unroll
        for (unsigned j = 0; j < 16; ++j) { const unsigned c = xb_ld(&bar[XB_XCNT(j)]); sum += c; cnt += (c > 0u) ? 1u : 0u; mine = (j == x) ? c : mine; }
        if (sum == G) break;
        __builtin_amdgcn_s_sleep(1);
        if ((++sp & 255u) == 0u) { if (xb_ld(&bar[XB_TMO])) break; if (sp > XB_SPIN_CAP) { atomicAdd(&bar[XB_TMO], 1u); break; } }
    }
    nloc = mine > 0u ? mine : 1u; nx = cnt > 0u ? cnt : 1u;
}

__device__ __forceinline__ void xcd_barrier(const XcdBarrier& b) {
    asm volatile("s_waitcnt vmcnt(0)" ::: "memory");
    __syncthreads();
    if (threadIdx.x == 0) {
        unsigned* bar = b.bar;
        __builtin_amdgcn_s_waitcnt(0);
        unsigned nloc = b.st[0], nx = b.st[1];
        if (nloc == 0u) { xcd_barrier_complete(bar, b.x, nloc, nx); b.st[0] = nloc; b.st[1] = nx; }
        const unsigned old = xb_add(&bar[XB_XSUB(b.x)], 1u);
        const unsigned gen = old / nloc;
        if (old + 1u == (gen + 1u) * nloc) {
            __builtin_amdgcn_fence(__ATOMIC_RELEASE, "agent");
            asm volatile("s_waitcnt vmcnt(0)" ::: "memory");
            const unsigned og = xb_add(&bar[XB_TOP], 1u);
            const unsigned tg = og / nx;
            if (og + 1u == (tg + 1u) * nx) xb_add(&bar[XB_TOPGEN], 1u);
            else XB_SPIN(xb_ld(&bar[XB_TOPGEN]) == tg, bar);
            __builtin_amdgcn_fence(__ATOMIC_ACQUIRE, "agent");
            xb_add(&bar[XB_XGEN(b.x)], 1u);
            asm volatile("s_waitcnt vmcnt(0)" ::: "memory");
        } else {
            XB_SPIN(xb_ld(&bar[XB_XGEN(b.x)]) == gen, bar);
            __builtin_amdgcn_fence(__ATOMIC_ACQUIRE, "agent");
            asm volatile("s_waitcnt vmcnt(0)" ::: "memory");
        }
    }
    __syncthreads();
}
#ifndef SKIP_SG
#define SKIP_SG 0
#endif
#define GEMM_P(EPI, Aptr, Bptr, NN, KK, E) do { int kk_ = (KK), nn_ = (NN); asm volatile("" : "+s"(kk_), "+s"(nn_)); pg8::Gemm g_{(const bf16_t*)(Aptr), (const bf16_t*)(Bptr), MP, nn_, kk_}; pg8::StaticOrder S_; int bid_ = blockIdx.x; asm volatile("" : "+s"(bid_)); S_.init(MP, nn_, (int)gridDim.x, bid_); \
    pg8::gemm_phase<EPI, pg8::StaticOrder, true, true>(lds, g_, S_, (E), mk_tid(wave_s)); } while (0)
__global__ void __launch_bounds__(512, 2) mega_fwd(Args a_unused) {
    extern __shared__ __attribute__((aligned(16))) unsigned char lds_raw[];
    LAS unsigned char* lds = (LAS unsigned char*)lds_raw;
    cg::grid_group grid = cg::this_grid();
#define GSYNC() xcd_barrier(xbar)
    ArgsP a = (ArgsP)__builtin_amdgcn_kernarg_segment_ptr();
    const int wave_s = __builtin_amdgcn_readfirstlane((int)threadIdx.x >> 6);
#define RELOAD() asm volatile("" : "+s"(a))
    constexpr size_t RKV_STRIDE = (33 * MiB) / 2;
    { unsigned* bw = (unsigned*)(a->ws + WS_BAR); if (blockIdx.x == 0) for (int q = threadIdx.x; q < XCD_BAR_WORDS; q += 512) bw[q] = 0u;
      if (threadIdx.x < 64) ((LAS unsigned*)(lds + 131072))[threadIdx.x] = 0u; }
#ifndef NO_INIT
    phase_init(a, mk_tid(wave_s));
#endif
    grid.sync();
    XcdBarrier xbar = xcd_barrier_post((unsigned*)(a->ws + WS_BAR), (volatile LAS unsigned*)(lds + 131072 + 32));
    for (int l = 0; l < 4; ++l) {
        RELOAD();
#ifndef NO_CONV
        convert_layer(a, l, lds, mk_tid(wave_s));
#endif
        GSYNC();
        for (int part = 0; part < 3; ++part) {
            RELOAD();
            unsigned char* ws = a->ws; bf16_t* W = (bf16_t*)(ws + WS_W); float* x = a->out; bf16_t* xb = (bf16_t*)(ws + WS_XB); float* ss = (float*)(ws + WS_SS); float* xs = x + (size_t)MP * D;
            const bf16_t* rA; const bf16_t* rB; int rK, rKc; float rscale;
            if (part != 1) { const int j = part >> 1; const bf16_t* Wgu = W + (j ? WE_GU1 : WE_GU0); const float* ssk = ss + (size_t)((3 * l + part) & 1) * MP * 16; bf16_t* act = (bf16_t*)(ws + WS_A0);
                { EpiSwiglu E{ssk, act}; GEMM_P(EpiSwiglu, xb, Wgu, NGU, D, E); }
                if (!SKIP_SG) sgemm<2>(mk_tid(wave_s), 176, 1, D, Wgu, D, ALx{xs}, SEpiSwiglu{act + (size_t)MP * FF});
                GSYNC();
                rA = act; rB = W + (j ? WE_DN1 : WE_DN0); rK = FF; rKc = 352; rscale = 0.5f;
            } else if ((l & 1) == 0) { const float* ssk = ss + (size_t)((3 * l + 1) & 1) * MP * 16; bf16_t* z = (bf16_t*)(ws + WS_Z);
                { EpiZ E{ssk, z}; GEMM_P(EpiZ, xb, W + WE_IN, NIN, D, E); }
                if (!SKIP_SG) sgemm<2>(mk_tid(wave_s), 40, 1, D, W + WE_IN, D, ALx{xs}, SEpiZ{z + (size_t)MP * NIN});
                GSYNC();
#ifndef NO_ATTN
                phase_attn(a, l >> 1, lds, mk_tid(wave_s));
#ifdef DUP_ATTN
                GSYNC(); phase_attn(a, l >> 1, lds, mk_tid(wave_s));
#endif
#endif
                GSYNC();
                rA = (const bf16_t*)(ws + WS_CAT); rB = W + WE_OUT; rK = D; rKc = 128; rscale = 1.f;
            } else {
#ifndef NO_SHIFT
                phase_shift(a, l, mk_tid(wave_s));
#endif
                GSYNC();
                { bf16_t* hh = (bf16_t*)(ws + WS_HH); bf16_t* rkv = (bf16_t*)(ws + WS_R); bf16_t* lora = (bf16_t*)(ws + WS_LORA);
                  { EpiRkvl E{rkv, RKV_STRIDE, lora}; GEMM_P(EpiRkvl, hh, W + WE_RKVL, NRKVL, 2048, E); }
                  if (!SKIP_SG) sgemm<2>(mk_tid(wave_s), 104, 1, 2048, W + WE_RKVL, 2048, ALbf16{hh + (size_t)MP * 2048, 2048}, SEpiRkvl{rkv + (size_t)MP * D, RKV_STRIDE, lora + (size_t)MP * 256}); }
                GSYNC();
                { const int i = l >> 1; bf16_t* lora = (bf16_t*)(ws + WS_LORA); float* ldp = (float*)(ws + WS_LD); bf16_t* aa = (bf16_t*)(ws + WS_AA); bf16_t* gg = (bf16_t*)(ws + WS_G);
                  const float* w0 = a->in[22] + i * D; const float* a0 = a->in[25] + i * D;
                  { EpiWag E{w0, a0, ldp, aa, gg}; GEMM_P(EpiWag, lora, W + WE_WAG, NWAG, 256, E); }
                  if (!SKIP_SG) sgemm<2>(mk_tid(wave_s), 96, 1, 256, W + WE_WAG, 256, ALbf16{lora + (size_t)MP * 256, 256}, SEpiWag{w0, a0, ldp + (size_t)MP * D, aa + (size_t)MP * D, gg + (size_t)MP * D}); }
                GSYNC();
#ifndef NO_SCAN
                phase_scan(a, l, lds, mk_tid(wave_s));
#ifdef DUP_SCAN
                GSYNC(); phase_scan(a, l, lds, mk_tid(wave_s));
#endif
#endif
                GSYNC();
                phase_post(a, l, mk_tid(wave_s));
                GSYNC();
                rA = (const bf16_t*)(ws + WS_AWO); rB = W + WE_WO; rK = D; rKc = 128; rscale = 1.f;
            }
            { EpiResid E{x, xb, ss + (size_t)((3 * l + part + 1) & 1) * MP * 16, rscale}; GEMM_P(EpiResid, rA, rB, D, rK, E); }
            if (!SKIP_SG) sgemm_resid(mk_tid(wave_s), lds, rA + (size_t)MP * rK, rB, rK, xs, rscale);
            GSYNC();
        }
    }
    RELOAD();
#ifndef NO_FINAL
    phase_final(a, mk_tid(wave_s));
#endif
}
extern "C" void kernel_launch(void* const* d_in, const int* in_sizes, int n_in, void* d_out, int out_size, void* d_ws, size_t ws_size, hipStream_t stream) {
    static int grid = 0;
    if (grid == 0) {
        int dev = 0, cus = 0, per_cu = 0;
        if (n_in != 37 || out_size != (int)O_END || ws_size < WS_END) { fprintf(stderr, "kernel_launch: unexpected shapes: n_in %d out %d ws %zu (need %zu)\n", n_in, out_size, ws_size, (size_t)WS_END); grid = -1; return; }
        hipGetDevice(&dev); hipDeviceGetAttribute(&cus, hipDeviceAttributeMultiprocessorCount, dev);
        if (hipFuncSetAttribute((const void*)mega_fwd, hipFuncAttributeMaxDynamicSharedMemorySize, LDS_BYTES) != hipSuccess) { fprintf(stderr, "kernel_launch: hipFuncSetAttribute failed\n"); grid = -1; return; }
        hipOccupancyMaxActiveBlocksPerMultiprocessor(&per_cu, (const void*)mega_fwd, 512, LDS_BYTES);
        (void)hipGetLastError();
        if (per_cu < 1) per_cu = 1;
        grid = cus;
        fprintf(stderr, "kernel_launch: cus %d per_cu %d grid %d\n", cus, per_cu, grid);
    }
    if (grid < 0) return;
    Args a{};
    for (int i = 0; i < 37; ++i) a.in[i] = (const float*)d_in[i];
    a.out = (float*)d_out; a.ws = (unsigned char*)d_ws; a.ph_lo = 0; a.ph_hi = 0;
    void* args[] = {&a};
    hipError_t e = hipLaunchCooperativeKernel((const void*)mega_fwd, dim3(grid), dim3(512), args, LDS_BYTES, stream);
    if (e != hipSuccess) fprintf(stderr, "kernel_launch: cooperative launch failed: %s\n", hipGetErrorString(e));
}
```

```cpp
#include <hip/hip_runtime.h>
#include <hip/hip_cooperative_groups.h>
#include <cstdio>
#include <cstdint>
namespace cg = cooperative_groups;
namespace pg8 {
#define PG8_LAS __attribute__((address_space(3)))
typedef unsigned short bf16_t;
typedef short bf16x8 __attribute__((ext_vector_type(8)));
typedef float f32x4 __attribute__((ext_vector_type(4)));
typedef unsigned u32x4 __attribute__((ext_vector_type(4)));
constexpr int BM = 256, BK = 64, HALF = 128, HTB = HALF * BK * 2  , STAGE_BYTES = 8 * HTB, NXCD = 8, WGM = 8;

__host__ __device__ __forceinline__ int lds_byte(int r, int c) { const int st = (r >> 4) * 2 + (c >> 5), rr = r & 15, cc = c & 31, ob = rr * 64 + cc * 2; return st * 1024 + (ob ^ (((ob >> 9) & 1) << 5)); }
__host__ __device__ __forceinline__ void stage_rc(int b, int& R, int& C) { const int st = b / 1024, sb = b % 1024, swz = sb ^ (((sb >> 9) & 1) << 5); R = (st >> 1) * 16 + swz / 64; C = (st & 1) * 32 + (swz % 64) / 2; }
__host__ __device__ __forceinline__ int perm32(int rho) { const int n = rho >> 4, i = rho & 15; return 8 * (i >> 2) + 4 * n + (i & 3); }

struct Unit { int pm, pn; };
struct Gemm { const bf16_t* A; const bf16_t* Bt; int M, N, K; };

struct StaticOrder {
    int nM, nN, nwg, G, c;
    __host__ __device__ void init(int M, int N, int G_, int c_) { nM = M / BM; nN = N / BM; nwg = nM * nN; G = G_; c = c_; }
    __host__ __device__ bool next(int i, Unit& u) const {
        const long L = (long)i * G + c; if (L >= nwg) return false;
        int wgid = (int)L; { const int q = nwg / NXCD, r = nwg % NXCD, xcd = wgid % NXCD, off = wgid / NXCD; wgid = (xcd < r ? xcd * (q + 1) : r * (q + 1) + (xcd - r) * q) + off; }
        const int nig = WGM * nN, gid = wgid / nig, fm = gid * WGM, gsz = (nM - fm) < WGM ? (nM - fm) : WGM;
        u.pm = fm + ((wgid % nig) % gsz); u.pn = (wgid % nig) / gsz; return true;
    }
    __device__ __forceinline__ void a_ready(const Unit&) const {}
    __device__ __forceinline__ void done(const Unit&) const {}
};

typedef float f32x2 __attribute__((ext_vector_type(2)));
template <class Epi, class Sched, bool ALIGN_EPI = false, bool SP2 = false>
__device__ __forceinline__ void gemm_phase(PG8_LAS unsigned char* lds, const Gemm g, const Sched& S, const Epi& E, int tid_in) {
    int tid_ = tid_in; asm volatile("" : "+v"(tid_));
    const int tid = tid_, wid = __builtin_amdgcn_readfirstlane(tid >> 6), lane = tid & 63, wr = wid >> 2, wc = wid & 3, fr = lane & 15, fq = lane >> 4;
    const int K = g.K, nt = K / BK;
    unsigned voffA[2], voffB[2];
#pragma unroll
    for (int i = 0; i < 2; ++i) { int R, C; stage_rc(tid * 16 + i * 8192, R, C); const int Rb = Epi::PERM ? ((R & ~31) + perm32(R & 31)) : R;
        voffA[i] = (unsigned)(R * K + C) * 2u; voffB[i] = (unsigned)(Rb * K + C) * 2u; }
    const size_t kstep = (size_t)(BK * 2);
    const size_t hstep = (size_t)HALF * K * 2;
    const size_t tstep = 2 * hstep;
    const unsigned ldsw = (unsigned)wid * 1024u;
    const int aoff = lds_byte(wr * 64 + fr, fq * 8), boff = lds_byte(wc * 32 + fr, fq * 8);
#define PG8_SA(b, h) (((b) * 2 + (h)) * HTB)
#define PG8_SB(b, h) ((4 + (b) * 2 + (h)) * HTB)
#define PG8_STAGE(bufoff, gbase, voff) do { _Pragma("unroll") for (int _i = 0; _i < 2; ++_i) \
        __builtin_amdgcn_global_load_lds((const unsigned*)((const char*)(gbase) + (voff)[_i]), (PG8_LAS unsigned*)(lds + (bufoff) + ldsw + _i * 8192), 16, 0, 0); } while (0)
#define PG8_LDA(dst, b, h) do { _Pragma("unroll") for (int m = 0; m < 4; ++m) _Pragma("unroll") for (int k = 0; k < 2; ++k) dst[m][k] = *(const PG8_LAS bf16x8*)(lds + PG8_SA(b, h) + aoff + m * 2048 + k * 1024); } while (0)
#define PG8_LDB(dst, b, h) do { _Pragma("unroll") for (int n = 0; n < 2; ++n) _Pragma("unroll") for (int k = 0; k < 2; ++k) dst[n][k] = *(const PG8_LAS bf16x8*)(lds + PG8_SB(b, h) + boff + n * 2048 + k * 1024); } while (0)
#define PG8_MMA(ai, bj, At, Bt) do { __builtin_amdgcn_s_setprio(1); _Pragma("unroll") for (int m = 0; m < 4; ++m) _Pragma("unroll") for (int n = 0; n < 2; ++n) _Pragma("unroll") for (int k = 0; k < 2; ++k) \
        acc[ai][bj][m][n] = __builtin_amdgcn_mfma_f32_16x16x32_bf16(Bt[n][k], At[m][k], acc[ai][bj][m][n], 0, 0, 0); __builtin_amdgcn_s_setprio(0); } while (0)
#define PG8_WAIT_V(n) asm volatile("s_waitcnt vmcnt(" #n ")" ::: "memory")
#define PG8_WAIT_L(n) asm volatile("s_waitcnt lgkmcnt(" #n ")" ::: "memory")
#define PG8_BAR __builtin_amdgcn_s_barrier()
#define PG8_SCHED __builtin_amdgcn_sched_barrier(0)
    Unit cur, nxt; int ui = 0;
    if (!S.next(0, cur)) return;
    f32x4 acc[2][2][4][2];
#pragma unroll
    for (int a = 0; a < 2; ++a)
#pragma unroll
        for (int b = 0; b < 2; ++b)
#pragma unroll
            for (int m = 0; m < 4; ++m)
#pragma unroll
                for (int n = 0; n < 2; ++n) acc[a][b][m][n] = (f32x4){0.f, 0.f, 0.f, 0.f};
    bf16x8 At[4][2], B0[2][2], B1[2][2];
    const char* cA = (const char*)g.A + (size_t)cur.pm * tstep; const char* cB = (const char*)g.Bt + (size_t)cur.pn * tstep;
    S.a_ready(cur);
    if constexpr (SP2) {
        PG8_STAGE(PG8_SB(0, 0), cB, voffB); PG8_STAGE(PG8_SB(0, 1), cB + hstep, voffB); PG8_STAGE(PG8_SA(0, 0), cA, voffA); PG8_STAGE(PG8_SA(0, 1), cA + hstep, voffA);
        if (wr == 1) PG8_BAR;
        PG8_WAIT_V(2); PG8_BAR;
        PG8_STAGE(PG8_SB(1, 0), cB + kstep, voffB); PG8_STAGE(PG8_SA(1, 0), cA + kstep, voffA); PG8_STAGE(PG8_SB(1, 1), cB + hstep + kstep, voffB);
        PG8_WAIT_V(6); PG8_BAR;
    } else {
        PG8_STAGE(PG8_SB(0, 0), cB, voffB); PG8_STAGE(PG8_SA(0, 0), cA, voffA); PG8_STAGE(PG8_SB(0, 1), cB + hstep, voffB); PG8_STAGE(PG8_SA(0, 1), cA + hstep, voffA);
        if (wr == 1) PG8_BAR;
        PG8_WAIT_V(4); PG8_BAR;
        PG8_STAGE(PG8_SB(1, 0), cB + kstep, voffB); PG8_STAGE(PG8_SA(1, 0), cA + kstep, voffA); PG8_STAGE(PG8_SB(1, 1), cB + hstep + kstep, voffB);
        PG8_WAIT_V(6); PG8_BAR;
    }
    for (;;) {
        const bool has_next = S.next(ui + 1, nxt);
        const char* nA = has_next ? (const char*)g.A + (size_t)nxt.pm * tstep : cA; const char* nB = has_next ? (const char*)g.Bt + (size_t)nxt.pn * tstep : cB;
        for (int t = 0; t < nt; t += 2) {
            const bool last = (t == nt - 2);
            const char* a1 = cA + (size_t)(t + 1) * kstep;
            const char* a2 = last ? nA : cA + (size_t)(t + 2) * kstep; const char* b2 = last ? nB : cB + (size_t)(t + 2) * kstep;
            const char* a3 = a2 + kstep; const char* b3 = b2 + kstep;
            if (last && has_next) S.a_ready(nxt);
            if constexpr (SP2) {
            PG8_LDB(B0, 0, 0); PG8_LDB(B1, 0, 1); PG8_SCHED; PG8_LDA(At, 0, 0); PG8_STAGE(PG8_SA(1, 1), a1 + hstep, voffA);
            PG8_WAIT_V(8); PG8_WAIT_L(0); PG8_BAR; PG8_MMA(0, 0, At, B0); PG8_MMA(0, 1, At, B1); PG8_BAR; PG8_SCHED;
            PG8_LDA(At, 0, 1); PG8_STAGE(PG8_SB(0, 0), b2, voffB); PG8_STAGE(PG8_SB(0, 1), b2 + hstep, voffB); PG8_STAGE(PG8_SA(0, 0), a2, voffA);
            PG8_WAIT_V(8); PG8_WAIT_L(0); PG8_BAR; PG8_MMA(1, 0, At, B0); PG8_MMA(1, 1, At, B1); PG8_BAR; PG8_SCHED;
            PG8_LDB(B0, 1, 0); PG8_LDB(B1, 1, 1); PG8_SCHED; PG8_LDA(At, 1, 0); PG8_STAGE(PG8_SA(0, 1), a2 + hstep, voffA);
            PG8_WAIT_V(8); PG8_WAIT_L(0); PG8_BAR; PG8_MMA(0, 0, At, B0); PG8_MMA(0, 1, At, B1); PG8_BAR; PG8_SCHED;
            PG8_LDA(At, 1, 1); PG8_STAGE(PG8_SB(1, 0), b3, voffB); PG8_STAGE(PG8_SB(1, 1), b3 + hstep, voffB); PG8_STAGE(PG8_SA(1, 0), a3, voffA);
            PG8_WAIT_V(8); PG8_WAIT_L(0); PG8_BAR; PG8_MMA(1, 0, At, B0); PG8_MMA(1, 1, At, B1); PG8_BAR; PG8_SCHED;
            } else {
            PG8_LDB(B0, 0, 0); PG8_SCHED; PG8_LDA(At, 0, 0); PG8_STAGE(PG8_SA(1, 1), a1 + hstep, voffA);
            PG8_WAIT_L(8); PG8_BAR; PG8_WAIT_L(0); PG8_MMA(0, 0, At, B0); PG8_BAR; PG8_SCHED;
            PG8_LDB(B1, 0, 1); PG8_STAGE(PG8_SB(0, 0), b2, voffB);
            PG8_BAR; PG8_WAIT_L(0); PG8_MMA(0, 1, At, B1); PG8_BAR;
            PG8_LDA(At, 0, 1); PG8_STAGE(PG8_SA(0, 0), a2, voffA);
            PG8_BAR; PG8_WAIT_L(0); PG8_MMA(1, 0, At, B0); PG8_BAR; PG8_SCHED;
            PG8_STAGE(PG8_SB(0, 1), b2 + hstep, voffB);
            PG8_WAIT_V(6); PG8_BAR; PG8_MMA(1, 1, At, B1); PG8_BAR;
            PG8_LDB(B0, 1, 0); PG8_SCHED; PG8_LDA(At, 1, 0); PG8_STAGE(PG8_SA(0, 1), a2 + hstep, voffA);
            PG8_WAIT_L(8); PG8_BAR; PG8_WAIT_L(0); PG8_MMA(0, 0, At, B0); PG8_BAR; PG8_SCHED;
            PG8_LDB(B1, 1, 1); PG8_STAGE(PG8_SB(1, 0), b3, voffB);
            PG8_BAR; PG8_WAIT_L(0); PG8_MMA(0, 1, At, B1); PG8_BAR;
            PG8_LDA(At, 1, 1); PG8_STAGE(PG8_SA(1, 0), a3, voffA);
            PG8_BAR; PG8_WAIT_L(0); PG8_MMA(1, 0, At, B0); PG8_BAR; PG8_SCHED;
            PG8_STAGE(PG8_SB(1, 1), b3 + hstep, voffB);
            PG8_WAIT_V(6); PG8_BAR; PG8_MMA(1, 1, At, B1); PG8_BAR;
            }
        }
        if constexpr (ALIGN_EPI) { if (wr == 0) PG8_BAR; }
        if constexpr (!Epi::AFTER_DRAIN) { E(acc, cur, wr, wc, fr, fq); S.done(cur); }
        if (!has_next) break;
#pragma unroll
        for (int a = 0; a < 2; ++a)
#pragma unroll
            for (int b = 0; b < 2; ++b)
#pragma unroll
                for (int m = 0; m < 4; ++m)
#pragma unroll
                    for (int n = 0; n < 2; ++n) acc[a][b][m][n] = (f32x4){0.f, 0.f, 0.f, 0.f};
        cur = nxt; cA = nA; cB = nB; ++ui;
        if constexpr (ALIGN_EPI) { if (wr == 1) PG8_BAR; }
    }
    PG8_WAIT_V(0);
    if constexpr (!ALIGN_EPI) { if (wr == 0) PG8_BAR; }
    PG8_BAR;
    if constexpr (Epi::AFTER_DRAIN) { E.fused(acc, cur, wr, wc, fr, fq, lds, wid, lane); S.done(cur); }
#undef PG8_SA
#undef PG8_SB
#undef PG8_STAGE
#undef PG8_LDA
#undef PG8_LDB
#undef PG8_MMA
#undef PG8_WAIT_V
#undef PG8_WAIT_L
#undef PG8_BAR
#undef PG8_SCHED
}
}
using pg8::bf16_t; using pg8::bf16x8; using pg8::f32x4;
typedef float f32x16 __attribute__((ext_vector_type(16)));
typedef unsigned u32x4 __attribute__((ext_vector_type(4)));
typedef unsigned u32x2 __attribute__((ext_vector_type(2)));
typedef short s16x4 __attribute__((ext_vector_type(4)));
#define LAS __attribute__((address_space(3)))
constexpr int MP = 16384, MS = 128, MT = 16512, D = 1024, FF = 2816, NGU = 5632, NIN = 1280, NRKVL = 3328, NWAG = 3072;
constexpr int SEQ = 4096, NB_P = 4, NB_S = 8, LS = 16;
constexpr size_t MiB = 1u << 20;
constexpr size_t WE_GU0 = 0, WE_DN0 = WE_GU0 + (size_t)NGU * D, WE_GU1 = WE_DN0 + (size_t)D * FF, WE_DN1 = WE_GU1 + (size_t)NGU * D, WE_MIX = WE_DN1 + (size_t)D * FF;
constexpr size_t WE_IN = WE_MIX, WE_OUT = WE_IN + (size_t)NIN * D;
constexpr size_t WE_RKVL = WE_MIX, WE_WAG = WE_RKVL + (size_t)NRKVL * 2048, WE_WO = WE_WAG + (size_t)NWAG * 256, WE_END = WE_WO + (size_t)D * D;
static_assert(WE_END * 2 <= 50 * MiB, "weights region");
constexpr size_t WS_W = 0, WS_XB = 50 * MiB  , WS_WEFF = 83 * MiB, WS_SS = 87 * MiB, WS_A0 = 89 * MiB, WS_B2 = 178 * MiB, WS_B3 = 286 * MiB, WS_BAR = 385 * MiB, WS_END = 386 * MiB;
constexpr size_t WS_Z = WS_A0, WS_CAT = WS_A0 + 41 * MiB, WS_HH = WS_A0, WS_LD = WS_A0;
constexpr size_t WS_R = WS_B2, WS_K = WS_B2 + 33 * MiB, WS_V = WS_B2 + 66 * MiB, WS_LORA = WS_B2 + 99 * MiB;
constexpr size_t WS_AA = WS_B3, WS_G = WS_B3 + 33 * MiB, WS_AWO = WS_B3 + 66 * MiB;
static_assert((size_t)MT * FF * 2 <= 89 * MiB && (size_t)MT * NIN * 2 <= 41 * MiB && (size_t)MT * D * 2 <= 33 * MiB && (size_t)MT * 256 * 2 <= 9 * MiB && (size_t)MT * D * 4 <= 89 * MiB, "arena");
constexpr size_t O_Y = 0, O_POOLP = 16908288, O_POOLS = 16969728, O_KP = 17092608, O_KS = 17223680, O_VP = 17485824, O_VS = 17616896, O_SHP = 17879040, O_SHS = 17887232, O_WKVP = 17903616, O_WKVS = 18427904, O_END = 19476480;
constexpr int LDS_BYTES = 131072 + 1024;
constexpr int GRID = 256;

struct Args { const float* in[37]; float* out; unsigned char* ws; int ph_lo, ph_hi; };
typedef const __attribute__((address_space(4))) Args* ArgsP;

__device__ __forceinline__ unsigned pk2(float lo, float hi) { typedef float f2 __attribute__((ext_vector_type(2))); typedef __bf16 b2 __attribute__((ext_vector_type(2))); f2 v = {lo, hi}; b2 b = __builtin_convertvector(v, b2); return __builtin_bit_cast(unsigned, b); }
__device__ __forceinline__ int mk_tid(int wave_s) { unsigned ones = ~0u; asm volatile("" : "+s"(ones)); const int lane = __builtin_amdgcn_mbcnt_hi(ones, __builtin_amdgcn_mbcnt_lo(ones, 0u)); return wave_s * 64 + lane; }
__device__ __forceinline__ float bflo(unsigned u) { return __builtin_bit_cast(float, u << 16); }
__device__ __forceinline__ float bfhi(unsigned u) { return __builtin_bit_cast(float, u & 0xffff0000u); }
__device__ __forceinline__ float sigmoidf_(float x) { return __builtin_amdgcn_rcpf(1.f + __expf(-x)); }
__device__ __forceinline__ float wave_sum(float v) {
#pragma unroll
    for (int o = 1; o < 64; o <<= 1) v += __shfl_xor(v, o);
    return v;
}
template <int CTRL> __device__ __forceinline__ float dpp_f(float v) { return __builtin_bit_cast(float, __builtin_amdgcn_update_dpp(0, __builtin_bit_cast(int, v), CTRL, 0xF, 0xF, true)); }
__device__ __forceinline__ float red8(float v) { v += dpp_f<0xB1>(v); v += dpp_f<0x4E>(v); v += dpp_f<0x141>(v); return v; }
__device__ __forceinline__ float red16(float v) { v = red8(v); v += dpp_f<0x140>(v); return v; }
__device__ __forceinline__ float ss_rstd(const float* ssrow) { const f32x4 a = *(const f32x4*)ssrow, b = *(const f32x4*)(ssrow + 4), c = *(const f32x4*)(ssrow + 8), d = *(const f32x4*)(ssrow + 12);
    const float s = ((a[0] + a[1]) + (a[2] + a[3])) + ((b[0] + b[1]) + (b[2] + b[3])) + ((c[0] + c[1]) + (c[2] + c[3])) + ((d[0] + d[1]) + (d[2] + d[3])); return rsqrtf(s * (1.f / D) + 1e-6f); }
__device__ __forceinline__ u32x4 pack8(const f32x4& a, const f32x4& b) { u32x4 w; w.x = pk2(a[0], a[1]); w.y = pk2(a[2], a[3]); w.z = pk2(b[0], b[1]); w.w = pk2(b[2], b[3]); return w; }
__device__ __forceinline__ u32x2 pack4(const f32x4& a) { u32x2 w; w.x = pk2(a[0], a[1]); w.y = pk2(a[2], a[3]); return w; }

__device__ __forceinline__ void load_xrow(const float* x, const bf16_t* xb, int m, int lane, f32x4 (&v)[4]) {
    if (m < MP) {
#pragma unroll
        for (int j = 0; j < 4; ++j) { const u32x2 o = *(const u32x2*)(xb + (size_t)m * D + 4 * lane + 256 * j); v[j] = (f32x4){bflo(o.x), bfhi(o.x), bflo(o.y), bfhi(o.y)}; } }
    else {
#pragma unroll
        for (int j = 0; j < 4; ++j) v[j] = *(const f32x4*)(x + (size_t)m * D + 4 * lane + 256 * j); }
}
#define EPI_LOOP_ROWS for (int am_ = 0; am_ < 8; ++am_)
#define EPI_AM const int ai = am_ >> 2, m = am_ & 3;
struct EpiSwiglu {
    static constexpr bool PERM = true, AFTER_DRAIN = false;
    const float* ss; bf16_t* act;
    __device__ __forceinline__ void operator()(const f32x4 (&acc)[2][2][4][2], const pg8::Unit& u, int wr, int wc, int fr, int fq) const { asm volatile("" : "+v"(fr), "+v"(fq));
#pragma unroll
        EPI_LOOP_ROWS { EPI_AM const int row = u.pm * 256 + ai * 128 + wr * 64 + m * 16 + fr; const float rstd = ss_rstd(ss + (size_t)row * 16);
#pragma unroll
            for (int bj = 0; bj < 2; ++bj) { const int col0 = u.pn * 256 + bj * 128 + wc * 32 + 8 * fq; const f32x4 g = acc[ai][bj][m][0] * rstd, up = acc[ai][bj][m][1] * rstd; f32x4 o;
#pragma unroll
                for (int j = 0; j < 4; ++j) o[j] = g[j] * sigmoidf_(g[j]) * up[j];
                *(u32x2*)(act + (size_t)row * FF + (col0 >> 1)) = pack4(o); } }
    }
};
struct EpiResid {
    static constexpr bool PERM = true, AFTER_DRAIN = false;
    bf16_t* xb; float* ssn; float scale;
    __device__ __forceinline__ void operator()(const f32x4 (&acc)[2][2][4][2], const pg8::Unit& u, int wr, int wc, int fr, int fq) const { asm volatile("" : "+v"(fr), "+v"(fq));
#pragma unroll
        for (int am_ = 0; am_ < 8; ++am_) { const int ai = am_ >> 2, m = am_ & 3; const int row = u.pm * 256 + ai * 128 + wr * 64 + m * 16 + fr; float sq = 0.f;
#pragma unroll
            for (int bj = 0; bj < 2; ++bj) { const int col0 = u.pn * 256 + bj * 128 + wc * 32 + 8 * fq; bf16_t* xp = xb + (size_t)row * D + col0; const u32x4 o = *(const u32x4*)xp;
                f32x4 x0 = {bflo(o.x), bfhi(o.x), bflo(o.y), bfhi(o.y)}, x1 = {bflo(o.z), bfhi(o.z), bflo(o.w), bfhi(o.w)}; x0 += acc[ai][bj][m][0] * scale; x1 += acc[ai][bj][m][1] * scale;
                *(u32x4*)xp = pack8(x0, x1);
                sq += (x0[0] * x0[0] + x0[1] * x0[1]) + (x0[2] * x0[2] + x0[3] * x0[3]) + (x1[0] * x1[0] + x1[1] * x1[1]) + (x1[2] * x1[2] + x1[3] * x1[3]); }
            sq += __shfl_xor(sq, 16); sq += __shfl_xor(sq, 32);
            if (fq == 0) ssn[(size_t)row * 16 + u.pn * 4 + wc] = sq; }
    }
};
struct EpiZ {
    static constexpr bool PERM = true, AFTER_DRAIN = false;
    const float* ss; bf16_t* z;
    __device__ __forceinline__ void operator()(const f32x4 (&acc)[2][2][4][2], const pg8::Unit& u, int wr, int wc, int fr, int fq) const { asm volatile("" : "+v"(fr), "+v"(fq));
#pragma unroll
        EPI_LOOP_ROWS { EPI_AM const int row = u.pm * 256 + ai * 128 + wr * 64 + m * 16 + fr; const float rstd = ss_rstd(ss + (size_t)row * 16);
#pragma unroll
            for (int bj = 0; bj < 2; ++bj) { const int col0 = u.pn * 256 + bj * 128 + wc * 32 + 8 * fq;
                *(u32x4*)(z + (size_t)row * NIN + col0) = pack8(acc[ai][bj][m][0] * rstd, acc[ai][bj][m][1] * rstd); } }
    }
};
__device__ __forceinline__ float lora_act(float v, int c) { return c < 64 ? (1.f - 2.f * __builtin_amdgcn_rcpf(__expf(2.f * v) + 1.f)) : (c < 128 ? v : sigmoidf_(v)); }
struct EpiRkvl {
    static constexpr bool PERM = true, AFTER_DRAIN = false;
    bf16_t* rkv; size_t stride; bf16_t* lora;
    __device__ __forceinline__ void operator()(const f32x4 (&acc)[2][2][4][2], const pg8::Unit& u, int wr, int wc, int fr, int fq) const { asm volatile("" : "+v"(fr), "+v"(fq));
        const int t = u.pn >> 2; const int rb = u.pm * 256 + wr * 64 + fr, cb = wc * 32 + 8 * fq;
        if (t < 3) { bf16_t* base = rkv + t * stride + (size_t)rb * D + (u.pn & 3) * 256 + cb;
#pragma unroll
            for (int am_ = 0; am_ < 8; ++am_) { const int ai = am_ >> 2, m = am_ & 3;
#pragma unroll
                for (int bj = 0; bj < 2; ++bj) *(u32x4*)(base + (size_t)(ai * 128 + m * 16) * D + bj * 128) = pack8(acc[ai][bj][m][0], acc[ai][bj][m][1]); }
        } else { bf16_t* base = lora + (size_t)rb * 256 + cb;
#pragma unroll
            for (int am_ = 0; am_ < 8; ++am_) { const int ai = am_ >> 2, m = am_ & 3;
#pragma unroll
                for (int bj = 0; bj < 2; ++bj) { f32x4 a = acc[ai][bj][m][0], b = acc[ai][bj][m][1]; const int cl = bj * 128 + cb;
#pragma unroll
                    for (int j = 0; j < 4; ++j) { a[j] = lora_act(a[j], cl); b[j] = lora_act(b[j], cl); }
                    *(u32x4*)(base + (size_t)(ai * 128 + m * 16) * 256 + bj * 128) = pack8(a, b); } }
        }
    }
};
__device__ __forceinline__ float wag_w(float v) { const float y = -v; const float sp = fmaxf(y, 0.f) + __logf(1.f + __expf(-fabsf(y))); return -__expf(-sp - 0.5f); }
struct EpiWag {
    static constexpr bool PERM = true, AFTER_DRAIN = false;
    const float* w0; const float* a0; float* ld; bf16_t* aa; bf16_t* gg;
    __device__ __forceinline__ void operator()(const f32x4 (&acc)[2][2][4][2], const pg8::Unit& u, int wr, int wc, int fr, int fq) const { asm volatile("" : "+v"(fr), "+v"(fq));
        const int t = u.pn >> 2; const int cb = (u.pn & 3) * 256 + wc * 32 + 8 * fq; const int rb = u.pm * 256 + wr * 64 + fr;
        if (t == 0) {
#pragma unroll
            for (int bj = 0; bj < 2; ++bj) { const int c = cb + bj * 128; const f32x4 b0 = *(const f32x4*)(w0 + c), b1 = *(const f32x4*)(w0 + c + 4);
#pragma unroll
                for (int am_ = 0; am_ < 8; ++am_) { const int ai = am_ >> 2, m = am_ & 3; const int row = rb + ai * 128 + m * 16; f32x4 a = acc[ai][bj][m][0], b = acc[ai][bj][m][1];
#pragma unroll
                    for (int j = 0; j < 4; ++j) { a[j] = wag_w(a[j] + b0[j]); b[j] = wag_w(b[j] + b1[j]); }
                    *(f32x4*)(ld + (size_t)row * D + c) = a; *(f32x4*)(ld + (size_t)row * D + c + 4) = b; } }
        } else if (t == 1) {
#pragma unroll
            for (int bj = 0; bj < 2; ++bj) { const int c = cb + bj * 128; const f32x4 b0 = *(const f32x4*)(a0 + c), b1 = *(const f32x4*)(a0 + c + 4);
#pragma unroll
                for (int am_ = 0; am_ < 8; ++am_) { const int ai = am_ >> 2, m = am_ & 3; const int row = rb + ai * 128 + m * 16; f32x4 a = acc[ai][bj][m][0], b = acc[ai][bj][m][1];
#pragma unroll
                    for (int j = 0; j < 4; ++j) { a[j] = sigmoidf_(a[j] + b0[j]); b[j] = sigmoidf_(b[j] + b1[j]); }
                    *(u32x4*)(aa + (size_t)row * D + c) = pack8(a, b); } }
        } else {
#pragma unroll
            for (int bj = 0; bj < 2; ++bj) { const int c = cb + bj * 128;
#pragma unroll
                for (int am_ = 0; am_ < 8; ++am_) { const int ai = am_ >> 2, m = am_ & 3; const int row = rb + ai * 128 + m * 16;
                    *(u32x4*)(gg + (size_t)row * D + c) = pack8(acc[ai][bj][m][0], acc[ai][bj][m][1]); } }
        }
    }
};
#define MFMA16(a, b, c) __builtin_amdgcn_mfma_f32_16x16x32_bf16((a), (b), (c), 0, 0, 0)
struct ALbf16 { const bf16_t* A; int lda;
    __device__ __forceinline__ bf16x8 load(int row, int k, float& sq) const { return *(const bf16x8*)(A + (size_t)row * lda + k); } };
struct ALx { const float* x;
    __device__ __forceinline__ bf16x8 load(int row, int k, float& sq) const { const f32x4 a = *(const f32x4*)(x + (size_t)row * D + k), b = *(const f32x4*)(x + (size_t)row * D + k + 4);
        sq += (a[0] * a[0] + a[1] * a[1]) + (a[2] * a[2] + a[3] * a[3]) + (b[0] * b[0] + b[1] * b[1]) + (b[2] * b[2] + b[3] * b[3]); return __builtin_bit_cast(bf16x8, pack8(a, b)); } };
template <int NB, class AL, class EP>
__device__ __forceinline__ void sgemm(int tid, int wg_lo, int ntile, int ksplit, int Kc, const bf16_t* Bt, int ldb, const AL al, const EP ep) {
    const int lane = tid & 63, w = tid >> 6, fr = lane & 15, fq = lane >> 4, row = 16 * w + fr;
    if ((int)blockIdx.x < wg_lo) return;
    for (int t = GRID - 1 - blockIdx.x; t < ntile * ksplit; t += GRID - wg_lo) {
        const int tn = t % ntile, ks = t / ntile, kb = ks * Kc + 8 * fq;
        f32x4 acc[NB]; const bf16_t* bp[NB];
#pragma unroll
        for (int nb = 0; nb < NB; ++nb) { acc[nb] = (f32x4){0.f, 0.f, 0.f, 0.f}; bp[nb] = Bt + (size_t)ep.brow(tn, nb, fr) * ldb + kb; }
        float sq = 0.f;
#pragma unroll 8
        for (int k = 0; k < Kc; k += 32) { const bf16x8 a = al.load(row, kb + k, sq);
#pragma unroll
            for (int nb = 0; nb < NB; ++nb) { const bf16x8 b = *(const bf16x8*)(bp[nb] + k); acc[nb] = MFMA16(b, a, acc[nb]); } }
        sq += __shfl_xor(sq, 16); sq += __shfl_xor(sq, 32);
        ep(tn, row, fq, acc, sq);
    }
}
struct SEpiSwiglu { bf16_t* act;
    __device__ __forceinline__ int brow(int tn, int nb, int i) const { const int a = 32 * tn + 16 * (nb >> 1) + i; return 8 * (a >> 2) + 4 * (nb & 1) + (a & 3); }
    __device__ __forceinline__ void operator()(int tn, int row, int fq, const f32x4 (&acc)[4], float sq) const { const float rstd = rsqrtf(sq * (1.f / D) + 1e-6f);
#pragma unroll
        for (int h = 0; h < 2; ++h) { f32x4 o;
#pragma unroll
            for (int j = 0; j < 4; ++j) { const float g = acc[2 * h][j] * rstd; o[j] = g * sigmoidf_(g) * (acc[2 * h + 1][j] * rstd); }
            *(u32x2*)(act + (size_t)row * FF + 32 * tn + 16 * h + 4 * fq) = pack4(o); } } };
__device__ __forceinline__ void sgemm_resid(int tid, LAS unsigned char* lds, const bf16_t* A, const bf16_t* Bt, int K, float* x, float scale) {
    const int lane = tid & 63, w = tid >> 6, fr = lane & 15, fq = lane >> 4, Kc = K >> 3, kb = w * Kc + 8 * fq;
    LAS f32x4* part = (LAS f32x4*)lds;
    for (int t = GRID - 1 - blockIdx.x; t < 64; t += GRID) {
        f32x4 acc[8];
#pragma unroll
        for (int rb = 0; rb < 8; ++rb) acc[rb] = (f32x4){0.f, 0.f, 0.f, 0.f};
        const bf16_t* bp = Bt + (size_t)(16 * t + fr) * K + kb; const bf16_t* ap = A + (size_t)fr * K + kb;
        for (int k = 0; k < Kc; k += 128) { bf16x8 bv[4], av[4][8];
#pragma unroll
            for (int u = 0; u < 4; ++u) { const int kk = (k + 32 * u) < Kc ? (k + 32 * u) : k; bv[u] = *(const bf16x8*)(bp + kk);
#pragma unroll
                for (int rb = 0; rb < 8; ++rb) av[u][rb] = *(const bf16x8*)(ap + (size_t)(16 * rb) * K + kk); }
#pragma unroll
            for (int u = 0; u < 4; ++u) if (k + 32 * u < Kc) {
#pragma unroll
                for (int rb = 0; rb < 8; ++rb) acc[rb] = MFMA16(bv[u], av[u][rb], acc[rb]); } }
#pragma unroll
        for (int rb = 0; rb < 8; ++rb) part[(w * 8 + rb) * 64 + lane] = acc[rb];
        __syncthreads();
        { f32x4 s = part[w * 64 + lane];
#pragma unroll
            for (int ww = 1; ww < 8; ++ww) s += part[(ww * 8 + w) * 64 + lane];
            float* xp = x + (size_t)(16 * w + fr) * D + 16 * t + 4 * fq; f32x4 xv = *(const f32x4*)xp; xv += s * scale; *(f32x4*)xp = xv; }
        __syncthreads();
    }
}
struct SEpiZ { bf16_t* z;
    __device__ __forceinline__ int brow(int tn, int nb, int i) const { return 32 * tn + 16 * nb + i; }
    __device__ __forceinline__ void operator()(int tn, int row, int fq, const f32x4 (&acc)[2], float sq) const { const float rstd = rsqrtf(sq * (1.f / D) + 1e-6f);
#pragma unroll
        for (int nb = 0; nb < 2; ++nb) *(u32x2*)(z + (size_t)row * NIN + 32 * tn + 16 * nb + 4 * fq) = pack4(acc[nb] * rstd); } };
struct SEpiRkvl { bf16_t* rkv; size_t stride; bf16_t* lora;
    __device__ __forceinline__ int brow(int tn, int nb, int i) const { return 32 * tn + 16 * nb + i; }
    __device__ __forceinline__ void operator()(int tn, int row, int fq, const f32x4 (&acc)[2], float sq) const {
#pragma unroll
        for (int nb = 0; nb < 2; ++nb) { const int c = 32 * tn + 16 * nb + 4 * fq;
            if (c < 3072) *(u32x2*)(rkv + (size_t)(c >> 10) * stride + (size_t)row * D + (c & 1023)) = pack4(acc[nb]);
            else { f32x4 a = acc[nb]; const int cl = c - 3072;
#pragma unroll
                for (int j = 0; j < 4; ++j) a[j] = lora_act(a[j], cl);
                *(u32x2*)(lora + (size_t)row * 256 + cl) = pack4(a); } } } };
struct SEpiWag { const float* w0; const float* a0; float* ld; bf16_t* aa; bf16_t* gg;
    __device__ __forceinline__ int brow(int tn, int nb, int i) const { return 32 * tn + 16 * nb + i; }
    __device__ __forceinline__ void operator()(int tn, int row, int fq, const f32x4 (&acc)[2], float sq) const {
#pragma unroll
        for (int nb = 0; nb < 2; ++nb) { const int cc = 32 * tn + 16 * nb + 4 * fq, t = cc >> 10, c = cc & 1023; f32x4 a = acc[nb];
            if (t == 0) { const f32x4 b0 = *(const f32x4*)(w0 + c);
#pragma unroll
                for (int j = 0; j < 4; ++j) a[j] = wag_w(a[j] + b0[j]);
                *(f32x4*)(ld + (size_t)row * D + c) = a; }
            else if (t == 1) { const f32x4 b0 = *(const f32x4*)(a0 + c);
#pragma unroll
                for (int j = 0; j < 4; ++j) a[j] = sigmoidf_(a[j] + b0[j]);
                *(u32x2*)(aa + (size_t)row * D + c) = pack4(a); }
            else *(u32x2*)(gg + (size_t)row * D + c) = pack4(a); } } };
struct TrSpec { const float* W; int K, N; const float* ks; int ksmode; bf16_t* WT; int ldT, kofs, rowmode, rowoff; };
__device__ __forceinline__ TrSpec make_spec(ArgsP a, int l, int si) {
    TrSpec s; const int i = l >> 1; bf16_t* W = (bf16_t*)(a->ws + WS_W);
    s.ks = nullptr; s.ksmode = 0; s.kofs = 0; s.rowmode = 0; s.rowoff = 0;
    if (si < 6) { const int j = si / 3, t = si % 3; const size_t lj = (size_t)(l * 2 + j);
        if (t < 2) { s.W = (t == 0 ? a->in[9] : a->in[10]) + lj * D * FF; s.K = D; s.N = FF; s.ks = a->in[8] + lj * D; s.ksmode = 1; s.WT = W + (j ? WE_GU1 : WE_GU0); s.ldT = D; s.rowmode = 1 + t; }
        else { s.W = a->in[11] + lj * FF * D; s.K = FF; s.N = D; s.WT = W + (j ? WE_DN1 : WE_DN0); s.ldT = FF; }
        return s; }
    if ((l & 1) == 0) {
        if (si == 6) { s.W = a->in[13] + (size_t)i * D * NIN; s.K = D; s.N = NIN; s.ks = a->in[12] + l * D; s.ksmode = 1; s.WT = W + WE_IN; s.ldT = D; }
        else if (si == 7) { s.W = a->in[17] + (size_t)i * D * D + 512 * D; s.K = 512; s.N = D; s.WT = W + WE_OUT; s.ldT = D; s.kofs = 512; }
        else { s.W = (const float*)(a->ws + WS_WEFF) + (size_t)i * 512 * D; s.K = 512; s.N = D; s.WT = W + WE_OUT; s.ldT = D; }
    } else {
        if (si == 18) { s.W = a->in[35] + (size_t)i * D * D; s.K = D; s.N = D; s.WT = W + WE_WO; s.ldT = D; }
        else { const int q = (si - 6) >> 1, hi = (si - 6) & 1;
            const int n = q < 3 ? 1024 : (q < 5 ? 64 : 128);
            const float* src = q == 0 ? a->in[19] : q == 1 ? a->in[20] : q == 2 ? a->in[21] : q == 3 ? a->in[23] : q == 4 ? a->in[26] : a->in[28];
            const int mui = q == 0 ? 0 : q == 1 ? 2 : q == 2 ? 3 : q == 3 ? 1 : q == 4 ? 4 : 5;
            s.W = src + (size_t)i * D * n; s.K = D; s.N = n; s.ks = a->in[18] + (size_t)(i * 6 + mui) * D; s.ksmode = hi ? 1 : 2; s.WT = W + WE_RKVL; s.ldT = 2048; s.kofs = hi ? 1024 : 0;
            s.rowoff = q < 3 ? 1024 * q : (q == 3 ? 3072 : (q == 4 ? 3136 : 3200)); }
    }
    return s;
}
__device__ __forceinline__ void tr_item(const TrSpec& s, LAS float* scr, int item, int lane) {
    const int nblk = s.N / 32, kb = item / nblk, nb = item % nblk, k0 = 64 * kb, n0 = 32 * nb;
    f32x4 wv[8];
#pragma unroll
    for (int i = 0; i < 8; ++i) wv[i] = *(const f32x4*)(s.W + (size_t)(k0 + (lane >> 3) + 8 * i) * s.N + n0 + 4 * (lane & 7));
#pragma unroll
    for (int i = 0; i < 8; ++i) { const int kk = (lane >> 3) + 8 * i; f32x4 v = wv[i];
        if (s.ksmode) { const float m = s.ks[k0 + kk]; v = v * (s.ksmode == 1 ? m : 1.f - m); }
        LAS float* d = scr + kk * 33 + 4 * (lane & 7); d[0] = v[0]; d[1] = v[1]; d[2] = v[2]; d[3] = v[3]; }
    asm volatile("s_waitcnt lgkmcnt(0)" ::: "memory");
    const int c = lane & 7;
#pragma unroll
    for (int j = 0; j < 4; ++j) { const int n = (lane >> 3) + 8 * j; const LAS float* p = scr + (8 * c) * 33 + n; const int gn = n0 + n;
        const int drow = s.rowmode == 0 ? s.rowoff + gn : (8 * (gn >> 2) + (gn & 3) + (s.rowmode == 2 ? 4 : 0));
        u32x4 o; o.x = pk2(p[0 * 33], p[1 * 33]); o.y = pk2(p[2 * 33], p[3 * 33]); o.z = pk2(p[4 * 33], p[5 * 33]); o.w = pk2(p[6 * 33], p[7 * 33]);
        *(u32x4*)(s.WT + (size_t)drow * s.ldT + s.kofs + k0 + 8 * c) = o; }
    asm volatile("s_waitcnt lgkmcnt(0)" ::: "memory");
}
__device__ __forceinline__ void convert_layer(ArgsP a, int l, LAS unsigned char* lds, const int tid) {
    const int lane = tid & 63, wave = tid >> 6, gw = blockIdx.x * 8 + wave, NGW = GRID * 8;
    LAS float* scr = (LAS float*)(lds + wave * 16384);
    const int nspec = (l & 1) ? 19 : 9;
    int base = 0;
    for (int si = 0; si < nspec; ++si) { const TrSpec s = make_spec(a, l, si); const int items = (s.K / 64) * (s.N / 32);
        int first = gw - (base % NGW); if (first < 0) first += NGW;
        for (int it = first; it < items; it += NGW) tr_item(s, scr, it, lane);
        base += items; }
    if (l & 1) { const int i = l >> 1; bf16_t* WT = (bf16_t*)(a->ws + WS_W) + WE_WAG;
        for (int q = blockIdx.x * 512 + tid; q < NWAG * 32; q += GRID * 512) { const int n = q % NWAG, k0 = (q / NWAG) * 8, t = n >> 10, c = n & 1023;
            const float* src = nullptr; int kb = 0;
            if (t == 0 && k0 < 64) { src = a->in[24] + (size_t)i * 64 * D; kb = k0; } else if (t == 1 && k0 >= 64 && k0 < 128) { src = a->in[27] + (size_t)i * 64 * D; kb = k0 - 64; } else if (t == 2 && k0 >= 128) { src = a->in[29] + (size_t)i * 128 * D; kb = k0 - 128; }
            u32x4 o = {0u, 0u, 0u, 0u};
            if (src) { float v[8];
#pragma unroll
                for (int e = 0; e < 8; ++e) v[e] = src[(size_t)(kb + e) * D + c];
                o.x = pk2(v[0], v[1]); o.y = pk2(v[2], v[3]); o.z = pk2(v[4], v[5]); o.w = pk2(v[6], v[7]); }
            *(u32x4*)(WT + (size_t)n * 256 + k0) = o; } }
}
__device__ __forceinline__ void phase_init(ArgsP a, const int tid) {
    const int lane = tid & 63, gw = blockIdx.x * 8 + (tid >> 6), NGW = GRID * 8;
    float* x = a->out; bf16_t* xb = (bf16_t*)(a->ws + WS_XB); float* ss = (float*)(a->ws + WS_SS);
    for (int m = gw; m < MT; m += NGW) { const float* src = m < MP ? a->in[0] + (size_t)m * D : a->in[1] + (size_t)(m - MP) * D; float s = 0.f; f32x4 v[4];
#pragma unroll
        for (int j = 0; j < 4; ++j) { v[j] = *(const f32x4*)(src + 4 * lane + 256 * j); s += (v[j][0] * v[j][0] + v[j][1] * v[j][1]) + (v[j][2] * v[j][2] + v[j][3] * v[j][3]); }
        if (m < MP) { s = wave_sum(s); if (lane < 16) ss[(size_t)m * 16 + lane] = lane == 0 ? s : 0.f;
#pragma unroll
            for (int j = 0; j < 4; ++j) *(u32x2*)(xb + (size_t)m * D + 4 * lane + 256 * j) = pack4(v[j]); }
        else {
#pragma unroll
            for (int j = 0; j < 4; ++j) *(f32x4*)(x + (size_t)m * D + 4 * lane + 256 * j) = v[j]; } }
    const int gt = blockIdx.x * 512 + tid, NT = GRID * 512;
    float* weff = (float*)(a->ws + WS_WEFF);
    for (int q = gt; q < 2 * 512 * D; q += 2 * NT) {
        const int q1 = q + NT; float acc0 = 0.f, acc1 = 0.f;
        const int i0 = q >> 19, k0 = (q >> 10) & 511, n0 = q & 1023, g0 = k0 >> 7, i1 = q1 >> 19, k1 = (q1 >> 10) & 511, n1 = q1 & 1023, g1 = k1 >> 7;
        const float* pw0 = a->in[14] + ((size_t)(i0 * 4 + g0) * 128 + (k0 & 127)) * 128; const float* ps0 = a->in[15] + i0 * 512 + g0 * 128; const float* wo0 = a->in[17] + (size_t)i0 * D * D + (size_t)(g0 * 128) * D + n0;
        const float* pw1 = a->in[14] + ((size_t)(i1 * 4 + g1) * 128 + (k1 & 127)) * 128; const float* ps1 = a->in[15] + i1 * 512 + g1 * 128; const float* wo1 = a->in[17] + (size_t)i1 * D * D + (size_t)(g1 * 128) * D + n1;
        for (int d0 = 0; d0 < 128; d0 += 16) { float w0[16], w1[16];
#pragma unroll
            for (int e = 0; e < 16; ++e) { w0[e] = wo0[(size_t)(d0 + e) * D]; w1[e] = wo1[(size_t)(d0 + e) * D]; }
#pragma unroll
            for (int e = 0; e < 16; ++e) { acc0 += pw0[d0 + e] * ps0[d0 + e] * w0[e]; acc1 += pw1[d0 + e] * ps1[d0 + e] * w1[e]; } }
        weff[q] = acc0; weff[q1] = acc1; }
}
__device__ __forceinline__ void phase_final(ArgsP a, const int tid) {
    const int lane = tid & 63, gw = blockIdx.x * 8 + (tid >> 6), NGW = GRID * 8; float* x = a->out; const float* gn = a->in[36]; const bf16_t* xbp = (const bf16_t*)(a->ws + WS_XB);
    for (int m = 2 * gw; m < MT; m += 2 * NGW) { float s0 = 0.f, s1 = 0.f; f32x4 v[4], u[4];
#pragma unroll
        for (int j = 0; j < 4; ++j) { v[j] = (f32x4){0.f, 0.f, 0.f, 0.f}; u[j] = v[j]; }
        load_xrow(x, xbp, m, lane, v); load_xrow(x, xbp, m + 1, lane, u);
#pragma unroll
        for (int j = 0; j < 4; ++j) { s0 += (v[j][0] * v[j][0] + v[j][1] * v[j][1]) + (v[j][2] * v[j][2] + v[j][3] * v[j][3]); s1 += (u[j][0] * u[j][0] + u[j][1] * u[j][1]) + (u[j][2] * u[j][2] + u[j][3] * u[j][3]); }
        const float r0 = rsqrtf(wave_sum(s0) * (1.f / D) + 1e-6f), r1 = rsqrtf(wave_sum(s1) * (1.f / D) + 1e-6f);
#pragma unroll
        for (int j = 0; j < 4; ++j) { const f32x4 g = *(const f32x4*)(gn + 4 * lane + 256 * j); *(f32x4*)(x + (size_t)m * D + 4 * lane + 256 * j) = v[j] * r0 * g; *(f32x4*)(x + (size_t)(m + 1) * D + 4 * lane + 256 * j) = u[j] * r1 * g; } }
}
__device__ __forceinline__ void shift_store(ArgsP a, int i, size_t m, int c, const f32x4& h, const f32x4& hp) {
    bf16_t* hh = (bf16_t*)(a->ws + WS_HH); *(u32x2*)(hh + m * 2048 + c) = pack4(h); *(u32x2*)(hh + m * 2048 + 1024 + c) = pack4(hp);
}
__device__ __forceinline__ void phase_shift(ArgsP a, int l, const int tid) {
    const int i = l >> 1, lane = tid & 63, gw = blockIdx.x * 8 + (tid >> 6), NGW = GRID * 8;
    const float* x = a->out; const float* gn = a->in[12] + l * D; const bf16_t* xbp = (const bf16_t*)(a->ws + WS_XB);
    for (int m = 2 * gw; m < MT; m += 2 * NGW) { int b, t; const bool smp = m >= MP; if (!smp) { b = m >> 12; t = m & 4095; } else { b = (m - MP) >> 4; t = (m - MP) & 15; }
        f32x4 v[4], u[4], p[4]; float s0 = 0.f, s1 = 0.f, sp = 0.f;
#pragma unroll
        for (int j = 0; j < 4; ++j) p[j] = (f32x4){0.f, 0.f, 0.f, 0.f};
        load_xrow(x, xbp, m, lane, v); load_xrow(x, xbp, m + 1, lane, u); if (t > 0) load_xrow(x, xbp, m - 1, lane, p);
#pragma unroll
        for (int j = 0; j < 4; ++j) { s0 += (v[j][0] * v[j][0] + v[j][1] * v[j][1]) + (v[j][2] * v[j][2] + v[j][3] * v[j][3]); s1 += (u[j][0] * u[j][0] + u[j][1] * u[j][1]) + (u[j][2] * u[j][2] + u[j][3] * u[j][3]); sp += (p[j][0] * p[j][0] + p[j][1] * p[j][1]) + (p[j][2] * p[j][2] + p[j][3] * p[j][3]); }
        const float r0 = rsqrtf(wave_sum(s0) * (1.f / D) + 1e-6f), r1 = rsqrtf(wave_sum(s1) * (1.f / D) + 1e-6f), rp = rsqrtf(wave_sum(sp) * (1.f / D) + 1e-6f);
#pragma unroll
        for (int j = 0; j < 4; ++j) { const int c = 4 * lane + 256 * j; const f32x4 g = *(const f32x4*)(gn + c); const f32x4 h0 = v[j] * r0 * g, h1 = u[j] * r1 * g; f32x4 hp;
            if (t > 0) hp = p[j] * rp * g; else if (smp) hp = *(const f32x4*)(a->in[5] + (size_t)(i * NB_S + b) * D + c); else hp = (f32x4){0.f, 0.f, 0.f, 0.f};
            shift_store(a, i, (size_t)m, c, h0, hp); shift_store(a, i, (size_t)m + 1, c, h1, h0);
            if (!smp && t + 1 == SEQ - 1) *(f32x4*)(a->out + O_SHP + (size_t)(i * NB_P + b) * D + c) = h1;
            if (smp && t + 1 == LS - 1) *(f32x4*)(a->out + O_SHS + (size_t)(i * NB_S + b) * D + c) = h1; } }
}
#define MFMA32(a, b, c) __builtin_amdgcn_mfma_f32_32x32x16_bf16((a), (b), (c), 0, 0, 0)
__device__ __forceinline__ int t5_bucket(int rel) { const int n = rel < 0 ? -rel : rel; const int side = rel > 0 ? 16 : 0;
    const int b = n < 8 ? n : n < 12 ? 8 : n < 16 ? 9 : n < 23 ? 10 : n < 32 ? 11 : n < 46 ? 12 : n < 64 ? 13 : n < 91 ? 14 : 15; return side + b; }
__device__ __forceinline__ void phase_attn(ArgsP a, int i, LAS unsigned char* lds, const int tid) {
    const bf16_t* z = (const bf16_t*)(a->ws + WS_Z); bf16_t* cat = (bf16_t*)(a->ws + WS_CAT);
    LAS bf16_t* Kl = (LAS bf16_t*)lds;
    LAS bf16_t* Vt = (LAS bf16_t*)(lds + 27648);
    LAS float* bl = (LAS float*)(lds + 27648 + 25600);
    const int lane = tid & 63, w = tid >> 6, r = lane & 31, h = lane >> 5;
    const float* t5 = a->in[7];
    const int vcu = ((int)blockIdx.x & 7) * (GRID >> 3) + ((int)blockIdx.x >> 3);
    const int hk = vcu & 1;
    for (int q = tid; q < 1024; q += 512) { const int g = q >> 8, ri = q & 255; bl[q] = ri < 255 ? t5[t5_bucket(ri - 191) * 8 + hk * 4 + g] : 0.f; }
    for (int u = vcu; u < 512 + 16; u += GRID) { asm volatile("" : "+s"(u));
        const bool smp = u >= 512; int b, c;
        if (!smp) { c = (u >> 1) & 63; b = u >> 7; } else { b = (u - 512) >> 1; c = 2; }
        int g, iq, qrow; if (!smp) { g = w >> 1; iq = 32 * (w & 1) + r; qrow = b * SEQ + 64 * c + iq; } else { g = (2 * w + (r >> 4)) & 3; iq = r & 15; qrow = MP + b * LS + iq; }
        const int head = hk * 4 + g;
        u32x4 kreg[3], vreg[3];
#pragma unroll
        for (int it = 0; it < 3; ++it) { const int q = tid + 512 * it, j = q >> 3, ch = q & 7; u32x4 kv = {0u, 0u, 0u, 0u}, vv = {0u, 0u, 0u, 0u};
            if (!smp) { const int t = 64 * (c - 2) + j; if (t >= 0) { const bf16_t* p = z + (size_t)(b * SEQ + t) * NIN + 1024 + hk * 64 + ch * 8; kv = *(const u32x4*)p; vv = *(const u32x4*)(p + 128); } }
            else if (j < 128) { const size_t o = ((size_t)((i * NB_S + b) * 128 + j) * 2 + hk) * 64 + ch * 8;
                kv = pack8(*(const f32x4*)(a->in[3] + o), *(const f32x4*)(a->in[3] + o + 4)); vv = pack8(*(const f32x4*)(a->in[4] + o), *(const f32x4*)(a->in[4] + o + 4)); }
            else if (j < 144) { const bf16_t* p = z + (size_t)(MP + b * LS + (j - 128)) * NIN + 1024 + hk * 64 + ch * 8; kv = *(const u32x4*)p; vv = *(const u32x4*)(p + 128); }
            kreg[it] = kv; vreg[it] = vv; }
        bf16x8 qf[4];
#pragma unroll
        for (int s = 0; s < 4; ++s) qf[s] = *(const bf16x8*)(z + (size_t)qrow * NIN + 512 + head * 64 + 16 * s + 8 * h);
#pragma unroll
        for (int it = 0; it < 3; ++it) { const int q = tid + 512 * it, j = q >> 3, ch = q & 7; const u32x4 vv = vreg[it];
            *(LAS u32x4*)(Kl + j * 72 + ch * 8) = kreg[it];
            LAS bf16_t* vp = Vt + (ch * 8) * 200 + j;
            vp[0] = (bf16_t)(vv.x & 0xffffu); vp[200] = (bf16_t)(vv.x >> 16); vp[400] = (bf16_t)(vv.y & 0xffffu); vp[600] = (bf16_t)(vv.y >> 16);
            vp[800] = (bf16_t)(vv.z & 0xffffu); vp[1000] = (bf16_t)(vv.z >> 16); vp[1200] = (bf16_t)(vv.w & 0xffffu); vp[1400] = (bf16_t)(vv.w >> 16); }
        __syncthreads();
        if (!smp || w < 2) {
            const float sink = a->in[16][i * 8 + head];
            f32x16 st[6];
#pragma unroll
            for (int kb = 0; kb < 6; ++kb) {
#pragma unroll
                for (int e = 0; e < 16; ++e) st[kb][e] = 0.f;
#pragma unroll
                for (int s = 0; s < 4; ++s) { const bf16x8 kf = *(const LAS bf16x8*)(Kl + (32 * kb + r) * 72 + 16 * s + 8 * h); st[kb] = MFMA32(kf, qf[s], st[kb]); } }
            const int kmin = smp ? 0 : (c >= 2 ? 0 : 128 - 64 * c), kmax = smp ? 144 : 192;
            float mx = sink; const LAS float* blp = bl + g * 256 - iq + 63;
#pragma unroll
            for (int kb = 0; kb < 6; ++kb)
#pragma unroll
                for (int e = 0; e < 16; ++e) { const int key = 32 * kb + (e & 3) + 8 * (e >> 2) + 4 * h; float s = st[kb][e] * 0.125f + blp[key]; if (key < kmin || key >= kmax) s = -1e30f; st[kb][e] = s; mx = fmaxf(mx, s); }
            mx = fmaxf(mx, __shfl_xor(mx, 32));
            float sum = 0.f;
#pragma unroll
            for (int kb = 0; kb < 6; ++kb)
#pragma unroll
                for (int e = 0; e < 16; ++e) { const float p = __expf(st[kb][e] - mx); st[kb][e] = p; sum += p; }
            sum += __shfl_xor(sum, 32); const float inv = 1.f / (sum + __expf(sink - mx));
            f32x16 o[2];
#pragma unroll
            for (int e = 0; e < 16; ++e) { o[0][e] = 0.f; o[1][e] = 0.f; }
#pragma unroll
            for (int kb = 0; kb < 6; ++kb)
#pragma unroll
                for (int s2 = 0; s2 < 2; ++s2) { u32x4 pw; pw.x = pk2(st[kb][8 * s2], st[kb][8 * s2 + 1]); pw.y = pk2(st[kb][8 * s2 + 2], st[kb][8 * s2 + 3]); pw.z = pk2(st[kb][8 * s2 + 4], st[kb][8 * s2 + 5]); pw.w = pk2(st[kb][8 * s2 + 6], st[kb][8 * s2 + 7]);
                    const bf16x8 pf = __builtin_bit_cast(bf16x8, pw);
#pragma unroll
                    for (int db = 0; db < 2; ++db) { const LAS bf16_t* vp = Vt + (32 * db + r) * 200 + 32 * kb + 16 * s2 + 4 * h; const u32x2 lo = *(const LAS u32x2*)vp, hi = *(const LAS u32x2*)(vp + 8);
                        u32x4 vw; vw.x = lo.x; vw.y = lo.y; vw.z = hi.x; vw.w = hi.y; o[db] = MFMA32(__builtin_bit_cast(bf16x8, vw), pf, o[db]); } }
#pragma unroll
            for (int db = 0; db < 2; ++db)
#pragma unroll
                for (int rg = 0; rg < 4; ++rg) { const int d0 = 32 * db + 8 * rg + 4 * h; f32x4 v = {o[db][4 * rg] * inv, o[db][4 * rg + 1] * inv, o[db][4 * rg + 2] * inv, o[db][4 * rg + 3] * inv};
                    *(u32x2*)(cat + (size_t)qrow * D + 512 + head * 64 + d0) = pack4(v); }
        }
        __syncthreads();
    }
    const int gt = blockIdx.x * 512 + tid, NT = GRID * 512;
    for (int q = gt; q < MT * 64; q += NT) { const int m = q >> 6, c0 = (q & 63) * 8, wdw = 2 << (c0 >> 7); const bool smp = m >= MP; int b, t; if (!smp) { b = m >> 12; t = m & 4095; } else { b = (m - MP) >> 4; t = (m - MP) & 15; }
        u32x4 zz[16];
#pragma unroll
        for (int d = 0; d < 16; ++d) { const int dd = (d < wdw && t - d >= 0) ? d : 0; zz[d] = *(const u32x4*)(z + (size_t)(m - dd) * NIN + c0); }
        float s[8];
#pragma unroll
        for (int e = 0; e < 8; ++e) s[e] = 0.f;
#pragma unroll
        for (int d = 1; d < 16; ++d) { const float mk = (d < wdw && t - d >= 0) ? 1.f : 0.f;
            s[0] += mk * bflo(zz[d].x); s[1] += mk * bfhi(zz[d].x); s[2] += mk * bflo(zz[d].y); s[3] += mk * bfhi(zz[d].y); s[4] += mk * bflo(zz[d].z); s[5] += mk * bfhi(zz[d].z); s[6] += mk * bflo(zz[d].w); s[7] += mk * bfhi(zz[d].w); }
        if (smp) { for (int d = t + 1; d < wdw; ++d) { const float* hp = a->in[2] + ((size_t)(i * NB_S + b) * 15 + 15 + t - d) * 512 + c0; const f32x4 h0 = *(const f32x4*)hp, h1 = *(const f32x4*)(hp + 4);
                s[0] += h0[0]; s[1] += h0[1]; s[2] += h0[2]; s[3] += h0[3]; s[4] += h1[0]; s[5] += h1[1]; s[6] += h1[2]; s[7] += h1[3]; } }
        const float cur[8] = {bflo(zz[0].x), bfhi(zz[0].x), bflo(zz[0].y), bfhi(zz[0].y), bflo(zz[0].z), bfhi(zz[0].z), bflo(zz[0].w), bfhi(zz[0].w)};
        const float rc = 1.f / (float)(smp ? wdw : (wdw < t + 1 ? wdw : t + 1));
        f32x4 o0, o1;
#pragma unroll
        for (int e = 0; e < 4; ++e) { o0[e] = (s[e] + cur[e]) * rc - cur[e]; o1[e] = (s[4 + e] + cur[4 + e]) * rc - cur[4 + e]; }
        *(u32x4*)(cat + (size_t)m * D + c0) = pack8(o0, o1); }
    for (int q = gt; q < NB_P * 15 * 512; q += NT) { const int c = q & 511, rr = (q >> 9) % 15, b = q / (15 * 512); a->out[O_POOLP + (size_t)i * NB_P * 15 * 512 + q] = bflo((unsigned)z[(size_t)(b * SEQ + SEQ - 15 + rr) * NIN + c]); }
    for (int q = gt; q < NB_S * 15 * 512; q += NT) { const int c = q & 511, rr = (q >> 9) % 15, b = q / (15 * 512); a->out[O_POOLS + (size_t)i * NB_S * 15 * 512 + q] = bflo((unsigned)z[(size_t)(MP + b * LS + 1 + rr) * NIN + c]); }
    for (int q = gt; q < NB_P * 128 * 128; q += NT) { const int cd = q & 127, rr = (q >> 7) & 127, b = q >> 14; const bf16_t* p = z + (size_t)(b * SEQ + SEQ - 128 + rr) * NIN + 1024 + cd;
        a->out[O_KP + (size_t)i * NB_P * 16384 + q] = bflo((unsigned)p[0]); a->out[O_VP + (size_t)i * NB_P * 16384 + q] = bflo((unsigned)p[128]); }
    for (int q = gt; q < NB_S * 128 * 128; q += NT) { const int cd = q & 127, rr = (q >> 7) & 127, b = q >> 14; float kv, vv;
        if (rr < 112) { const size_t o = ((size_t)(i * NB_S + b) * 128 + rr + 16) * 128 + cd; kv = a->in[3][o]; vv = a->in[4][o]; }
        else { const bf16_t* p = z + (size_t)(MP + b * LS + rr - 112) * NIN + 1024 + cd; kv = bflo((unsigned)p[0]); vv = bflo((unsigned)p[128]); }
        a->out[O_KS + (size_t)i * NB_S * 16384 + q] = kv; a->out[O_VS + (size_t)i * NB_S * 16384 + q] = vv; }
}
constexpr int SC_BUF = 32768, SC_YB = 2 * SC_BUF, SC_ARR = 2048;
struct ScanRaw { u32x4 r2, k2, v2, a2; f32x4 l0, l1; };
__device__ __forceinline__ void scan_load(ArgsP a, ScanRaw& R, int pt, int m0, int T, int hd) {
    const int ts = pt >> 3, c8 = (pt & 7) * 8;
    if (ts < T) { const size_t m = (size_t)(m0 + ts); const int hc = hd * 64 + c8; unsigned char* ws = a->ws;
        R.r2 = *(const u32x4*)((const bf16_t*)(ws + WS_R) + m * D + hc); R.k2 = *(const u32x4*)((const bf16_t*)(ws + WS_K) + m * D + hc); R.v2 = *(const u32x4*)((const bf16_t*)(ws + WS_V) + m * D + hc); R.a2 = *(const u32x4*)((const bf16_t*)(ws + WS_AA) + m * D + hc);
        R.l0 = *(const f32x4*)((const float*)(ws + WS_LD) + m * D + hc); R.l1 = *(const f32x4*)((const float*)(ws + WS_LD) + m * D + hc + 4); }
}
__device__ __forceinline__ void scan_prep(ArgsP a, const ScanRaw& R, LAS float* buf, int pt, int m0, int T, int hd, int rq, const f32x4 (&kk8)[2], const f32x4 (&ka8)[2], const f32x4 (&rk8)[2]) {
    const int ts = pt >> 3, c8 = (pt & 7) * 8;
    if (ts < T) { const size_t m = (size_t)(m0 + ts); unsigned char* ws = a->ws;
        const u32x4 r2 = R.r2, k2 = R.k2, v2 = R.v2, a2 = R.a2; const f32x4 l0 = R.l0, l1 = R.l1;
        const f32x4 r0 = {bflo(r2.x), bfhi(r2.x), bflo(r2.y), bfhi(r2.y)}, r1 = {bflo(r2.z), bfhi(r2.z), bflo(r2.w), bfhi(r2.w)};
        const f32x4 k0 = {bflo(k2.x), bfhi(k2.x), bflo(k2.y), bfhi(k2.y)}, k1 = {bflo(k2.z), bfhi(k2.z), bflo(k2.w), bfhi(k2.w)};
        const f32x4 v0 = {bflo(v2.x), bfhi(v2.x), bflo(v2.y), bfhi(v2.y)}, v1 = {bflo(v2.z), bfhi(v2.z), bflo(v2.w), bfhi(v2.w)};
        const f32x4 a0 = {bflo(a2.x), bfhi(a2.x), bflo(a2.y), bfhi(a2.y)}, a1 = {bflo(a2.z), bfhi(a2.z), bflo(a2.w), bfhi(a2.w)};
        f32x4 q0 = k0 * kk8[0], q1 = k1 * kk8[1];
        float ssq = ((q0[0] * q0[0] + q0[1] * q0[1]) + (q0[2] * q0[2] + q0[3] * q0[3])) + ((q1[0] * q1[0] + q1[1] * q1[1]) + (q1[2] * q1[2] + q1[3] * q1[3])); ssq = red8(ssq);
        const float inv = rsqrtf(fmaxf(ssq, 1e-24f)); q0 = q0 * inv; q1 = q1 * inv;
        const f32x4 p0 = k0 * (1.f + (a0 - 1.f) * ka8[0]), p1 = k1 * (1.f + (a1 - 1.f) * ka8[1]); f32x4 d0, d1;
#pragma unroll
        for (int e = 0; e < 4; ++e) { d0[e] = __expf(l0[e]); d1[e] = __expf(l1[e]); }
        const f32x4 t0 = r0 * p0 * rk8[0], t1 = r1 * p1 * rk8[1]; float bo = ((t0[0] + t0[1]) + (t0[2] + t0[3])) + ((t1[0] + t1[1]) + (t1[2] + t1[3])); bo = red8(bo);
        { typedef __fp16 h2_t __attribute__((ext_vector_type(2)));
#define PKH(x, y) __builtin_bit_cast(unsigned, (h2_t)__builtin_amdgcn_cvt_pkrtz((x), (y)))
          const f32x4 bb0 = q0 * a0, bb1 = q1 * a1; LAS unsigned* hb = (LAS unsigned*)buf + (ts * 16 + (c8 >> 2)) * 4;
          *(LAS u32x4*)(hb) = (u32x4){PKH(-q0[0], -q0[1]), PKH(-q0[2], -q0[3]), PKH(bb0[0], bb0[1]), PKH(bb0[2], bb0[3])};
          *(LAS u32x4*)(hb + 4) = (u32x4){PKH(-q1[0], -q1[1]), PKH(-q1[2], -q1[3]), PKH(bb1[0], bb1[1]), PKH(bb1[2], bb1[3])};
          *(LAS u32x4*)(hb + SC_ARR) = (u32x4){PKH(p0[0], p0[1]), PKH(p0[2], p0[3]), PKH(r0[0], r0[1]), PKH(r0[2], r0[3])};
          *(LAS u32x4*)(hb + SC_ARR + 4) = (u32x4){PKH(p1[0], p1[1]), PKH(p1[2], p1[3]), PKH(r1[0], r1[1]), PKH(r1[2], r1[3])};
          { const f32x4 e0 = d0 - 1.f, e1 = d1 - 1.f; LAS unsigned* eb = (LAS unsigned*)buf + 2 * SC_ARR + ((ts >> 1) & 1) * 512 + ((ts >> 2) * 16 + (c8 >> 2)) * 4 + (ts & 1) * 2;
            *(LAS u32x2*)(eb) = (u32x2){PKH(e0[0], e0[1]), PKH(e0[2], e0[3])}; *(LAS u32x2*)(eb + 4) = (u32x2){PKH(e1[0], e1[1]), PKH(e1[2], e1[3])}; }
#undef PKH
          LAS float* vt = buf + 3 * SC_ARR + c8 * 32 + ts;
          vt[0] = v0[0]; vt[32] = v0[1]; vt[64] = v0[2]; vt[96] = v0[3]; vt[128] = v1[0]; vt[160] = v1[1]; vt[192] = v1[2]; vt[224] = v1[3]; }
        if (rq == 0 && (pt & 7) == 0) ((float*)(ws + WS_LORA))[m * 16 + hd] = bo; }
}
#define DPP_ADD(x, ctrl) "v_add_f32_dpp " x ", " x ", " x " " ctrl " row_mask:0xf bank_mask:0xf bound_ctrl:1\n\t"
#define MIX_SH(d, s, h, c, hi) "v_fma_mix_f32 " d ", " s ", " h ", " c " op_sel:[0," hi ",0] op_sel_hi:[0,1,0]\n\t"
#define MIX_HS(d, h, s, hi) "v_fma_mix_f32 " d ", " h ", " s ", " d " op_sel:[" hi ",0,0] op_sel_hi:[1,0,0]\n\t"
__device__ __forceinline__ void scan_step(f32x4& S, float& ypo, const u32x4& h0, const u32x4& h1, unsigned e01, unsigned e23, unsigned r01, unsigned r23, float vi) {
    float s0 = S[0], s1 = S[1], s2 = S[2], s3 = S[3], sa, yp, sb;
    asm volatile(
        MIX_SH("%[sa]", "%[s0]", "%[n01]", "0", "0") MIX_SH("%[sb]", "%[s2]", "%[n23]", "0", "0") MIX_SH("%[yp]", "%[s0]", "%[r01]", "0", "0")
        MIX_SH("%[sa]", "%[s1]", "%[n01]", "%[sa]", "1") MIX_SH("%[sb]", "%[s3]", "%[n23]", "%[sb]", "1") MIX_SH("%[yp]", "%[s1]", "%[r01]", "%[yp]", "1")
        "v_add_f32 %[sa], %[sa], %[sb]\n\t" MIX_SH("%[yp]", "%[s2]", "%[r23]", "%[yp]", "0") MIX_SH("%[yp]", "%[s3]", "%[r23]", "%[yp]", "1")
        "v_fma_mix_f32 %[s0], %[e01], %[s0], %[s0] op_sel:[0,0,0] op_sel_hi:[1,0,0]\n\t" "v_fma_mix_f32 %[s1], %[e01], %[s1], %[s1] op_sel:[1,0,0] op_sel_hi:[1,0,0]\n\t"
        DPP_ADD("%[sa]", "quad_perm:[1,0,3,2]") DPP_ADD("%[yp]", "quad_perm:[1,0,3,2]")
        "v_fma_mix_f32 %[s2], %[e23], %[s2], %[s2] op_sel:[0,0,0] op_sel_hi:[1,0,0]\n\t" "v_fma_mix_f32 %[s3], %[e23], %[s3], %[s3] op_sel:[1,0,0] op_sel_hi:[1,0,0]\n\t"
        DPP_ADD("%[sa]", "quad_perm:[2,3,0,1]") DPP_ADD("%[yp]", "quad_perm:[2,3,0,1]")
        MIX_HS("%[s0]", "%[p01]", "%[vi]", "0") MIX_HS("%[s1]", "%[p01]", "%[vi]", "1")
        DPP_ADD("%[sa]", "row_half_mirror")
        MIX_HS("%[s2]", "%[p23]", "%[vi]", "0") MIX_HS("%[s3]", "%[p23]", "%[vi]", "1")
        DPP_ADD("%[sa]", "row_mirror")
        MIX_HS("%[s0]", "%[b01]", "%[sa]", "0") MIX_HS("%[s1]", "%[b01]", "%[sa]", "1") MIX_HS("%[s2]", "%[b23]", "%[sa]", "0") "v_fma_mix_f32 %[s3], %[b23], %[sa], %[s3] op_sel:[1,0,0] op_sel_hi:[1,0,0]"
        : [s0] "+v"(s0), [s1] "+v"(s1), [s2] "+v"(s2), [s3] "+v"(s3), [sa] "=&v"(sa), [yp] "=&v"(yp), [sb] "=&v"(sb)
        : [n01] "v"(h0.x), [n23] "v"(h0.y), [b01] "v"(h0.z), [b23] "v"(h0.w), [p01] "v"(h1.x), [p23] "v"(h1.y), [r01] "v"(r01), [r23] "v"(r23),
          [e01] "v"(e01), [e23] "v"(e23), [vi] "v"(vi));
    S[0] = s0; S[1] = s1; S[2] = s2; S[3] = s3; ypo = yp;
}
__device__ __forceinline__ float h2f_lo(unsigned u) { return (float)__builtin_bit_cast(__fp16, (unsigned short)(u & 0xffffu)); }
__device__ __forceinline__ float h2f_hi(unsigned u) { return (float)__builtin_bit_cast(__fp16, (unsigned short)(u >> 16)); }
template <bool FULL, int YS> __device__ __forceinline__ void scan_chunk(f32x4& S, const LAS unsigned* hp, const LAS unsigned* ep, const LAS float* vp, LAS float* yb, int T, bool ywr) {
    unsigned rp01 = 0u, rp23 = 0u;
    const int TT = FULL ? 32 : T;
    for (int t0 = 0; t0 < TT; t0 += 4) { u32x4 h0[4], h1[4]; const f32x4 v = *(const LAS f32x4*)(vp + t0); const u32x4 ea = *(const LAS u32x4*)(ep + t0 * 16), eb = *(const LAS u32x4*)(ep + 512 + t0 * 16);
#pragma unroll
        for (int k = 0; k < 4; ++k) { h0[k] = *(const LAS u32x4*)(hp + (t0 + k) * 64); h1[k] = *(const LAS u32x4*)(hp + SC_ARR + (t0 + k) * 64);
            __builtin_amdgcn_sched_barrier(0); }
        __builtin_amdgcn_sched_barrier(0);
        const unsigned e01[4] = {ea.x, ea.z, eb.x, eb.z}, e23[4] = {ea.y, ea.w, eb.y, eb.w};
        f32x4 yp;
#pragma unroll
        for (int k = 0; k < 4; ++k) { float y1; scan_step(S, y1, h0[k], h1[k], e01[k], e23[k], k == 0 ? rp01 : h1[k - 1].z, k == 0 ? rp23 : h1[k - 1].w, v[k]); yp[k] = y1; }
        if (ywr) *(LAS f32x4*)(yb + t0) = yp;
        rp01 = h1[3].z; rp23 = h1[3].w; __builtin_amdgcn_sched_barrier(0); }
    { float yp = __builtin_fmaf(S[3], h2f_hi(rp23), __builtin_fmaf(S[2], h2f_lo(rp23), __builtin_fmaf(S[1], h2f_hi(rp01), S[0] * h2f_lo(rp01)))); yp += dpp_f<0xB1>(yp); yp += dpp_f<0x4E>(yp); if (ywr) yb[TT] = yp; }
}
#define SCAN_BAR() asm volatile("s_waitcnt lgkmcnt(0)\n\ts_barrier" ::: "memory")
__device__ __forceinline__ void phase_scan(ArgsP a, int l, LAS unsigned char* lds, const int tid) {
    const int i = l >> 1, lane = tid & 63, w = tid >> 6, pt = tid - 256;
    const int rl = lane >> 4, cq = lane & 15, rloc = 4 * (w & 3) + rl;
    LAS float* ybuf = (LAS float*)(lds + SC_YB);
    LAS float* ydummy = ybuf + 1024 + (tid & 255);
    for (int task = blockIdx.x; task < 256 + 512; task += GRID) {
        const bool smp = task >= 256; const int tk = smp ? task - 256 : task, sq = tk >> 2, rq = tk & 3, b = sq >> 4, hd = sq & 15;
        const int L = smp ? LS : SEQ, row0 = smp ? MP + b * LS : b * SEQ, nch = (L + 31) >> 5, srow = 16 * rq + rloc;
        f32x4 S = {0.f, 0.f, 0.f, 0.f};
        if (smp && w < 4) S = *(const f32x4*)(a->in[6] + ((size_t)((i * NB_S + b) * 16 + hd) * 64 + srow) * 64 + 4 * cq);
        f32x4 kk8[2], ka8[2], rk8[2];
        { const int hc = hd * 64 + ((pt & 7) * 8 & 63); kk8[0] = *(const f32x4*)(a->in[30] + i * D + hc); kk8[1] = *(const f32x4*)(a->in[30] + i * D + hc + 4); ka8[0] = *(const f32x4*)(a->in[31] + i * D + hc); ka8[1] = *(const f32x4*)(a->in[31] + i * D + hc + 4);
          rk8[0] = *(const f32x4*)(a->in[32] + i * D + hc); rk8[1] = *(const f32x4*)(a->in[32] + i * D + hc + 4); }
        bf16_t* Y = (bf16_t*)a->out;
        ScanRaw R;
        if (w >= 4) { scan_load(a, R, pt, row0, L < 32 ? L : 32, hd); scan_prep(a, R, (LAS float*)lds, pt, row0, L < 32 ? L : 32, hd, rq, kk8, ka8, rk8); if (nch > 1) scan_load(a, R, pt, row0 + 32, 32, hd); }
        SCAN_BAR();
        for (int c = 0; c < nch; ++c) { const int T = (L - 32 * c) < 32 ? (L - 32 * c) : 32;
            if (w < 4) { const LAS unsigned* hp = (const LAS unsigned*)(lds + (c & 1) * SC_BUF) + 4 * cq; const LAS unsigned* ep = (const LAS unsigned*)(lds + (c & 1) * SC_BUF) + 2 * SC_ARR + 4 * cq; const LAS float* vp = (const LAS float*)(lds + (c & 1) * SC_BUF) + 3 * SC_ARR + srow * 32; LAS float* yb = ybuf + (c & 1) * 2304 + (rloc * 4 + (cq >> 2)) * 36;
                if (L - 32 * c >= 32) scan_chunk<true, 16>(S, hp, ep, vp, yb, 32, (cq & 3) == 0); else scan_chunk<false, 16>(S, hp, ep, vp, yb, L - 32 * c, (cq & 3) == 0);
            } else {
                if (c + 1 < nch) scan_prep(a, R, (LAS float*)(lds + ((c + 1) & 1) * SC_BUF), pt, row0 + 32 * (c + 1), 32, hd, rq, kk8, ka8, rk8);
                if (c + 2 < nch) scan_load(a, R, pt, row0 + 32 * (c + 2), 32, hd);
                if (c > 0) { const int ts = pt >> 3, r2 = (pt & 7) * 2; const LAS float* yp = ybuf + ((c - 1) & 1) * 2304 + r2 * 144 + ts + 1;
                    *(unsigned*)(Y + (size_t)(row0 + 32 * (c - 1) + ts) * D + hd * 64 + 16 * rq + r2) = pk2((yp[0] + yp[36]) + (yp[72] + yp[108]), (yp[144] + yp[180]) + (yp[216] + yp[252])); }
            }
            SCAN_BAR();
        }
        if (w >= 4) { const int c = nch - 1, T = (L - 32 * c) < 32 ? (L - 32 * c) : 32, ts = pt >> 3, r2 = (pt & 7) * 2; const LAS float* yp = ybuf + (c & 1) * 2304 + r2 * 144 + ts + 1;
            if (ts < T) *(unsigned*)(Y + (size_t)(row0 + 32 * c + ts) * D + hd * 64 + 16 * rq + r2) = pk2((yp[0] + yp[36]) + (yp[72] + yp[108]), (yp[144] + yp[180]) + (yp[216] + yp[252])); }
        else { float* so = a->out + (smp ? O_WKVS + (size_t)((i * NB_S + b) * 16 + hd) * 4096 : O_WKVP + (size_t)((i * NB_P + b) * 16 + hd) * 4096) + srow * 64 + 4 * cq; *(f32x4*)so = S; }
        __syncthreads();
    }
}
__device__ __forceinline__ void phase_post(ArgsP a, int l, const int tid) {
    const int i = l >> 1; unsigned char* ws = a->ws; const bf16_t* Y = (const bf16_t*)a->out; const bf16_t* Vb = (const bf16_t*)(ws + WS_V); const bf16_t* GG = (const bf16_t*)(ws + WS_G); const float* BO = (const float*)(ws + WS_LORA); bf16_t* AWO = (bf16_t*)(ws + WS_AWO);
    const float* lw = a->in[33] + i * D; const float* lb = a->in[34] + i * D;
    const int NT = GRID * 512;
    for (int q = blockIdx.x * 512 + tid; q < MT * 256; q += 2 * NT) {
#pragma unroll
        for (int rep = 0; rep < 2; ++rep) { const int qq = q + rep * NT; if (qq < MT * 256) { const size_t m = (size_t)(qq >> 8); const int c = (qq & 255) * 4;
        const u32x2 y2 = *(const u32x2*)(Y + m * D + c), v2 = *(const u32x2*)(Vb + m * D + c), g2 = *(const u32x2*)(GG + m * D + c); const float bo = BO[m * 16 + (c >> 6)];
        const f32x4 y4 = {bflo(y2.x), bfhi(y2.x), bflo(y2.y), bfhi(y2.y)}, v4 = {bflo(v2.x), bfhi(v2.x), bflo(v2.y), bfhi(v2.y)}, g4 = {bflo(g2.x), bfhi(g2.x), bflo(g2.y), bfhi(g2.y)};
        const float mean = red16((y4[0] + y4[1]) + (y4[2] + y4[3])) * (1.f / 64.f); const f32x4 dv = y4 - mean;
        const float var = red16((dv[0] * dv[0] + dv[1] * dv[1]) + (dv[2] * dv[2] + dv[3] * dv[3])) * (1.f / 64.f); const float rs = rsqrtf(var + 64e-5f);
        const f32x4 yn = dv * rs * *(const f32x4*)(lw + c) + *(const f32x4*)(lb + c);
        *(u32x2*)(AWO + m * D + c) = pack4((yn + v4 * bo) * g4); } } }
}
#define GAS __attribute__((address_space(1)))
#define XB_TMO      128
#define XB_XCNT(j)  (256  + 64 * (j))
#define XB_XSUB(j)  (1280 + 64 * (j))
#define XB_XGEN(j)  (2304 + 64 * (j))
#define XB_TOP      3328
#define XB_TOPGEN   3392
#define XCD_BAR_WORDS 3456
#define XB_SPIN_CAP (1u << 18)

__device__ __forceinline__ unsigned xb_ld(unsigned* p)              { return __hip_atomic_load(p, __ATOMIC_RELAXED, __HIP_MEMORY_SCOPE_AGENT); }
__device__ __forceinline__ unsigned xb_add(unsigned* p, unsigned v) { return __hip_atomic_fetch_add(p, v, __ATOMIC_RELAXED, __HIP_MEMORY_SCOPE_AGENT); }
__device__ __forceinline__ unsigned xb_xcc_id() { return (unsigned)__builtin_amdgcn_s_getreg((3 << 11) | 20) & 0xFu; }
#define XB_SPIN(cond, bar) do { unsigned _sp = 0; while (cond) { __builtin_amdgcn_s_sleep(1); \
    if ((++_sp & 255u) == 0u) { if (xb_ld(&(bar)[XB_TMO])) break; if (_sp > XB_SPIN_CAP) { atomicAdd(&(bar)[XB_TMO], 1u); break; } } } } while (0)

struct XcdBarrier {
    unsigned* bar; unsigned x;
    volatile LAS unsigned* st;
};

__device__ __forceinline__ XcdBarrier xcd_barrier_post(unsigned* bar, volatile LAS unsigned* st) {
    XcdBarrier b; b.bar = bar; b.x = xb_xcc_id(); b.st = st;
    if (threadIdx.x == 0) (void)xb_add(&bar[XB_XCNT(b.x)], 1u);
    return b;
}
__device__ __forceinline__ void xcd_barrier_complete(unsigned* bar, unsigned x, unsigned& nloc, unsigned& nx) {
    const unsigned G = gridDim.x * gridDim.y * gridDim.z;
    unsigned sum, cnt, mine, sp = 0u;
    for (;;) {
        sum = 0u; cnt = 0u; mine = 0u;
#pragma unroll
        for (unsigned j = 0; j < 16; ++j) { const unsigned c = xb_ld(&bar[XB_XCNT(j)]); sum += c; cnt += (c > 0u) ? 1u : 0u; }
        mine = xb_ld(&bar[XB_XCNT(x)]);
        if (sum == G) break;
        __builtin_amdgcn_s_sleep(1);
        if ((++sp & 255u) == 0u) { if (xb_ld(&bar[XB_TMO])) break; if (sp > XB_SPIN_CAP) { atomicAdd(&bar[XB_TMO], 1u); break; } }
    }
    nloc = mine > 0u ? mine : 1u; nx = cnt > 0u ? cnt : 1u;
}

__device__ __forceinline__ void xcd_barrier(const XcdBarrier& b, const int tid0) {
    asm volatile("s_waitcnt vmcnt(0)" ::: "memory");
    __syncthreads();
    if (tid0 == 0) {
        unsigned* bar = b.bar; asm volatile("" : "+s"(bar)); unsigned bx_ = b.x; asm volatile("" : "+s"(bx_));
        __builtin_amdgcn_s_waitcnt(0);
        unsigned nloc = b.st[0], nx = b.st[1];
        if (nloc == 0u) { xcd_barrier_complete(bar, bx_, nloc, nx); b.st[0] = nloc; b.st[1] = nx; }
        const unsigned old = xb_add(&bar[XB_XSUB(bx_)], 1u);
        const unsigned gen = old / nloc;
        if (old + 1u == (gen + 1u) * nloc) {
            __builtin_amdgcn_fence(__ATOMIC_RELEASE, "agent");
            asm volatile("s_waitcnt vmcnt(0)" ::: "memory");
            const unsigned og = xb_add(&bar[XB_TOP], 1u);
            const unsigned tg = og / nx;
            if (og + 1u == (tg + 1u) * nx) xb_add(&bar[XB_TOPGEN], 1u);
            else XB_SPIN(xb_ld(&bar[XB_TOPGEN]) == tg, bar);
            __builtin_amdgcn_fence(__ATOMIC_ACQUIRE, "agent");
            xb_add(&bar[XB_XGEN(bx_)], 1u);
            asm volatile("s_waitcnt vmcnt(0)" ::: "memory");
        } else {
            XB_SPIN(xb_ld(&bar[XB_XGEN(bx_)]) == gen, bar);
            __builtin_amdgcn_fence(__ATOMIC_ACQUIRE, "agent");
            asm volatile("s_waitcnt vmcnt(0)" ::: "memory");
        }
    }
    __syncthreads();
}
#ifndef SKIP_SG
#define SKIP_SG 0
#endif
#define GEMM_P(EPI, Aptr, Bptr, NN, KK, E) do { int kk_ = (KK), nn_ = (NN); asm volatile("" : "+s"(kk_), "+s"(nn_)); pg8::Gemm g_{(const bf16_t*)(Aptr), (const bf16_t*)(Bptr), MP, nn_, kk_}; pg8::StaticOrder S_; int bid_ = blockIdx.x; asm volatile("" : "+s"(bid_)); S_.init(MP, nn_, GRID, bid_); \
    pg8::gemm_phase<EPI, pg8::StaticOrder, true, true>(lds, g_, S_, (E), mk_tid(wave_s)); } while (0)
__global__ void __launch_bounds__(512, 2) mega_fwd(Args a_unused) {
    extern __shared__ __attribute__((aligned(16))) unsigned char lds_raw[];
    LAS unsigned char* lds = (LAS unsigned char*)lds_raw;
    cg::grid_group grid = cg::this_grid();
#define GSYNC() xcd_barrier(xbar, mk_tid(wave_s))
    ArgsP a = (ArgsP)__builtin_amdgcn_kernarg_segment_ptr();
    const int wave_s = __builtin_amdgcn_readfirstlane((int)threadIdx.x >> 6);
#define RELOAD() asm volatile("" : "+s"(a))
    constexpr size_t RKV_STRIDE = (33 * MiB) / 2;
    { unsigned* bw = (unsigned*)(a->ws + WS_BAR); if (blockIdx.x == 0) for (int q = threadIdx.x; q < XCD_BAR_WORDS; q += 512) bw[q] = 0u;
      if (threadIdx.x < 64) ((LAS unsigned*)(lds + 131072))[threadIdx.x] = 0u; }
#ifndef NO_INIT
    phase_init(a, mk_tid(wave_s));
#ifdef DUP_INIT
    phase_init(a, mk_tid(wave_s)); phase_init(a, mk_tid(wave_s));
#endif
#endif
    grid.sync();
    XcdBarrier xbar = xcd_barrier_post((unsigned*)(a->ws + WS_BAR), (volatile LAS unsigned*)(lds + 131072 + 32));
    for (int l = 0; l < 4; ++l) {
        RELOAD();
#ifndef NO_CONV
        convert_layer(a, l, lds, mk_tid(wave_s));
#ifdef DUP_CONV
        GSYNC(); convert_layer(a, l, lds, mk_tid(wave_s));
#endif
#endif
        GSYNC();
        for (int part = 0; part < 3; ++part) {
            RELOAD();
            unsigned char* ws = a->ws; bf16_t* W = (bf16_t*)(ws + WS_W); float* x = a->out; bf16_t* xb = (bf16_t*)(ws + WS_XB); float* ss = (float*)(ws + WS_SS); float* xs = x + (size_t)MP * D;
            const bf16_t* rA; const bf16_t* rB; int rK, rKc; float rscale;
            if (part != 1) { const int j = part >> 1; const bf16_t* Wgu = W + (j ? WE_GU1 : WE_GU0); const float* ssk = ss + (size_t)((3 * l + part) & 1) * MP * 16; bf16_t* act = (bf16_t*)(ws + WS_A0);
                { EpiSwiglu E{ssk, act}; GEMM_P(EpiSwiglu, xb, Wgu, NGU, D, E); }
#ifdef DUP_UP
                GSYNC(); { EpiSwiglu E{ssk, act}; GEMM_P(EpiSwiglu, xb, Wgu, NGU, D, E); }
#endif
                if (!SKIP_SG) sgemm<4>(mk_tid(wave_s), 128, 88, 1, D, Wgu, D, ALx{xs}, SEpiSwiglu{act + (size_t)MP * FF});
                GSYNC();
                rA = act; rB = W + (j ? WE_DN1 : WE_DN0); rK = FF; rKc = 352; rscale = 0.5f;
            } else if ((l & 1) == 0) { const float* ssk = ss + (size_t)((3 * l + 1) & 1) * MP * 16; bf16_t* z = (bf16_t*)(ws + WS_Z);
                { EpiZ E{ssk, z}; GEMM_P(EpiZ, xb, W + WE_IN, NIN, D, E); }
                if (!SKIP_SG) sgemm<2>(mk_tid(wave_s), 64, 40, 1, D, W + WE_IN, D, ALx{xs}, SEpiZ{z + (size_t)MP * NIN});
                GSYNC();
#ifndef NO_ATTN
                phase_attn(a, l >> 1, lds, mk_tid(wave_s));
#ifdef DUP_ATTN
                GSYNC(); phase_attn(a, l >> 1, lds, mk_tid(wave_s));
#endif
#endif
                GSYNC();
                rA = (const bf16_t*)(ws + WS_CAT); rB = W + WE_OUT; rK = D; rKc = 128; rscale = 1.f;
            } else {
#ifndef NO_SHIFT
                phase_shift(a, l, mk_tid(wave_s));
#ifdef DUP_SHIFT
                GSYNC(); phase_shift(a, l, mk_tid(wave_s));
#endif
#endif
                GSYNC();
                { bf16_t* hh = (bf16_t*)(ws + WS_HH); bf16_t* rkv = (bf16_t*)(ws + WS_R); bf16_t* lora = (bf16_t*)(ws + WS_LORA);
                  { EpiRkvl E{rkv, RKV_STRIDE, lora}; GEMM_P(EpiRkvl, hh, W + WE_RKVL, NRKVL, 2048, E); }
                  if (!SKIP_SG) sgemm<2>(mk_tid(wave_s), 64, 104, 1, 2048, W + WE_RKVL, 2048, ALbf16{hh + (size_t)MP * 2048, 2048}, SEpiRkvl{rkv + (size_t)MP * D, RKV_STRIDE, lora + (size_t)MP * 256}); }
                GSYNC();
                { const int i = l >> 1; bf16_t* lora = (bf16_t*)(ws + WS_LORA); float* ldp = (float*)(ws + WS_LD); bf16_t* aa = (bf16_t*)(ws + WS_AA); bf16_t* gg = (bf16_t*)(ws + WS_G);
                  const float* w0 = a->in[22] + i * D; const float* a0 = a->in[25] + i * D;
                  { EpiWag E{w0, a0, ldp, aa, gg}; GEMM_P(EpiWag, lora, W + WE_WAG, NWAG, 256, E); }
                  if (!SKIP_SG) sgemm<2>(mk_tid(wave_s), 0, 96, 1, 256, W + WE_WAG, 256, ALbf16{lora + (size_t)MP * 256, 256}, SEpiWag{w0, a0, ldp + (size_t)MP * D, aa + (size_t)MP * D, gg + (size_t)MP * D}); }
                GSYNC();
#ifndef NO_SCAN
                phase_scan(a, l, lds, mk_tid(wave_s));
#ifdef DUP_SCAN
                GSYNC(); phase_scan(a, l, lds, mk_tid(wave_s));
#endif
#endif
                GSYNC();
                phase_post(a, l, mk_tid(wave_s));
                GSYNC();
                rA = (const bf16_t*)(ws + WS_AWO); rB = W + WE_WO; rK = D; rKc = 128; rscale = 1.f;
            }
            { EpiResid E{xb, ss + (size_t)((3 * l + part + 1) & 1) * MP * 16, rscale}; GEMM_P(EpiResid, rA, rB, D, rK, E); }
            if (!SKIP_SG) sgemm_resid(mk_tid(wave_s), lds, rA + (size_t)MP * rK, rB, rK, xs, rscale);
            GSYNC();
        }
    }
    RELOAD();
#ifndef NO_FINAL
    phase_final(a, mk_tid(wave_s));
#endif
}
extern "C" void kernel_launch(void* const* d_in, const int* in_sizes, int n_in, void* d_out, int out_size, void* d_ws, size_t ws_size, hipStream_t stream) {
    static int grid = 0;
    if (grid == 0) {
        int dev = 0, cus = 0, per_cu = 0;
        if (n_in != 37 || out_size != (int)O_END || ws_size < WS_END) { fprintf(stderr, "kernel_launch: unexpected shapes: n_in %d out %d ws %zu (need %zu)\n", n_in, out_size, ws_size, (size_t)WS_END); grid = -1; return; }
        hipGetDevice(&dev); hipDeviceGetAttribute(&cus, hipDeviceAttributeMultiprocessorCount, dev);
        if (hipFuncSetAttribute((const void*)mega_fwd, hipFuncAttributeMaxDynamicSharedMemorySize, LDS_BYTES) != hipSuccess) { fprintf(stderr, "kernel_launch: hipFuncSetAttribute failed\n"); grid = -1; return; }
        hipOccupancyMaxActiveBlocksPerMultiprocessor(&per_cu, (const void*)mega_fwd, 512, LDS_BYTES);
        (void)hipGetLastError();
        if (per_cu < 1) per_cu = 1;
        grid = GRID;
        if (cus < GRID) fprintf(stderr, "kernel_launch: device has %d CUs, kernel needs %d co-resident workgroups\n", cus, GRID);
        fprintf(stderr, "kernel_launch: cus %d per_cu %d grid %d\n", cus, per_cu, grid);
    }
    if (grid < 0) return;
    Args a{};
    for (int i = 0; i < 37; ++i) a.in[i] = (const float*)d_in[i];
    a.out = (float*)d_out; a.ws = (unsigned char*)d_ws; a.ph_lo = 0; a.ph_hi = 0;
    void* args[] = {&a};
    hipError_t e = hipLaunchCooperativeKernel((const void*)mega_fwd, dim3(grid), dim3(512), args, LDS_BYTES, stream);
    if (e != hipSuccess) fprintf(stderr, "kernel_launch: cooperative launch failed: %s\n", hipGetErrorString(e));
}
```

```cpp
#include <hip/hip_runtime.h>
#include <hip/hip_cooperative_groups.h>
#include <cstdio>
#include <cstdint>
namespace cg = cooperative_groups;
namespace pg8 {
#define PG8_LAS __attribute__((address_space(3)))
typedef unsigned short bf16_t;
typedef short bf16x8 __attribute__((ext_vector_type(8)));
typedef float f32x4 __attribute__((ext_vector_type(4)));
typedef unsigned u32x4 __attribute__((ext_vector_type(4)));
constexpr int BM = 256, BK = 64, HALF = 128, HTB = HALF * BK * 2  , STAGE_BYTES = 8 * HTB, NXCD = 8, WGM = 8;

__host__ __device__ __forceinline__ int lds_byte(int r, int c) { const int st = (r >> 4) * 2 + (c >> 5), rr = r & 15, cc = c & 31, ob = rr * 64 + cc * 2; return st * 1024 + (ob ^ (((ob >> 9) & 1) << 5)); }
__host__ __device__ __forceinline__ void stage_rc(int b, int& R, int& C) { const int st = b / 1024, sb = b % 1024, swz = sb ^ (((sb >> 9) & 1) << 5); R = (st >> 1) * 16 + swz / 64; C = (st & 1) * 32 + (swz % 64) / 2; }
__host__ __device__ __forceinline__ int perm32(int rho) { const int n = rho >> 4, i = rho & 15; return 8 * (i >> 2) + 4 * n + (i & 3); }

struct Unit { int pm, pn; };
struct Gemm { const bf16_t* A; const bf16_t* Bt; int M, N, K; };

struct StaticOrder {
    int nM, nN, nwg, G, c;
    __host__ __device__ void init(int M, int N, int G_, int c_) { nM = M / BM; nN = N / BM; nwg = nM * nN; G = G_; c = c_; }
    __host__ __device__ bool next(int i, Unit& u) const {
        const long L = (long)i * G + c; if (L >= nwg) return false;
        int wgid = (int)L; { const int q = nwg / NXCD, r = nwg % NXCD, xcd = wgid % NXCD, off = wgid / NXCD; wgid = (xcd < r ? xcd * (q + 1) : r * (q + 1) + (xcd - r) * q) + off; }
        const int nig = WGM * nN, gid = wgid / nig, fm = gid * WGM, gsz = (nM - fm) < WGM ? (nM - fm) : WGM;
        u.pm = fm + ((wgid % nig) % gsz); u.pn = (wgid % nig) / gsz; return true;
    }
    __device__ __forceinline__ void a_ready(const Unit&) const {}
    __device__ __forceinline__ void done(const Unit&) const {}
};

typedef float f32x2 __attribute__((ext_vector_type(2)));
template <class Epi, class Sched, bool ALIGN_EPI = false, bool SP2 = false>
__device__ __forceinline__ void gemm_phase(PG8_LAS unsigned char* lds, const Gemm g, const Sched& S, const Epi& E, int tid_in) {
    int tid_ = tid_in; asm volatile("" : "+v"(tid_));
    const int tid = tid_, wid = __builtin_amdgcn_readfirstlane(tid >> 6), lane = tid & 63, wr = wid >> 2, wc = wid & 3, fr = lane & 15, fq = lane >> 4;
    const int K = g.K, nt = K / BK;
    unsigned voffA[2], voffB[2];
#pragma unroll
    for (int i = 0; i < 2; ++i) { int R, C; stage_rc(tid * 16 + i * 8192, R, C); const int Rb = Epi::PERM ? ((R & ~31) + perm32(R & 31)) : R;
        voffA[i] = (unsigned)(R * K + C) * 2u; voffB[i] = (unsigned)(Rb * K + C) * 2u; }
    const size_t kstep = (size_t)(BK * 2);
    const size_t hstep = (size_t)HALF * K * 2;
    const size_t tstep = 2 * hstep;
    const unsigned ldsw = (unsigned)wid * 1024u;
    const int aoff = lds_byte(wr * 64 + fr, fq * 8), boff = lds_byte(wc * 32 + fr, fq * 8);
#define PG8_SA(b, h) (((b) * 2 + (h)) * HTB)
#define PG8_SB(b, h) ((4 + (b) * 2 + (h)) * HTB)
#define PG8_STAGE(bufoff, gbase, voff) do { _Pragma("unroll") for (int _i = 0; _i < 2; ++_i) \
        __builtin_amdgcn_global_load_lds((const unsigned*)((const char*)(gbase) + (voff)[_i]), (PG8_LAS unsigned*)(lds + (bufoff) + ldsw + _i * 8192), 16, 0, 0); } while (0)
#define PG8_LDA(dst, b, h) do { _Pragma("unroll") for (int m = 0; m < 4; ++m) _Pragma("unroll") for (int k = 0; k < 2; ++k) dst[m][k] = *(const PG8_LAS bf16x8*)(lds + PG8_SA(b, h) + aoff + m * 2048 + k * 1024); } while (0)
#define PG8_LDB(dst, b, h) do { _Pragma("unroll") for (int n = 0; n < 2; ++n) _Pragma("unroll") for (int k = 0; k < 2; ++k) dst[n][k] = *(const PG8_LAS bf16x8*)(lds + PG8_SB(b, h) + boff + n * 2048 + k * 1024); } while (0)
#define PG8_MMA(ai, bj, At, Bt) do { __builtin_amdgcn_s_setprio(1); _Pragma("unroll") for (int m = 0; m < 4; ++m) _Pragma("unroll") for (int n = 0; n < 2; ++n) _Pragma("unroll") for (int k = 0; k < 2; ++k) \
        acc[ai][bj][m][n] = __builtin_amdgcn_mfma_f32_16x16x32_bf16(Bt[n][k], At[m][k], acc[ai][bj][m][n], 0, 0, 0); __builtin_amdgcn_s_setprio(0); } while (0)
#define PG8_WAIT_V(n) asm volatile("s_waitcnt vmcnt(" #n ")" ::: "memory")
#define PG8_WAIT_L(n) asm volatile("s_waitcnt lgkmcnt(" #n ")" ::: "memory")
#define PG8_BAR __builtin_amdgcn_s_barrier()
#define PG8_SCHED __builtin_amdgcn_sched_barrier(0)
    Unit cur, nxt; int ui = 0;
    if (!S.next(0, cur)) return;
    f32x4 acc[2][2][4][2];
#pragma unroll
    for (int a = 0; a < 2; ++a)
#pragma unroll
        for (int b = 0; b < 2; ++b)
#pragma unroll
            for (int m = 0; m < 4; ++m)
#pragma unroll
                for (int n = 0; n < 2; ++n) acc[a][b][m][n] = (f32x4){0.f, 0.f, 0.f, 0.f};
    bf16x8 At[4][2], B0[2][2], B1[2][2];
    const char* cA = (const char*)g.A + (size_t)cur.pm * tstep; const char* cB = (const char*)g.Bt + (size_t)cur.pn * tstep;
    S.a_ready(cur);
    if constexpr (SP2) {
        PG8_STAGE(PG8_SB(0, 0), cB, voffB); PG8_STAGE(PG8_SB(0, 1), cB + hstep, voffB); PG8_STAGE(PG8_SA(0, 0), cA, voffA); PG8_STAGE(PG8_SA(0, 1), cA + hstep, voffA);
        if (wr == 1) PG8_BAR;
        PG8_WAIT_V(2); PG8_BAR;
        PG8_STAGE(PG8_SB(1, 0), cB + kstep, voffB); PG8_STAGE(PG8_SA(1, 0), cA + kstep, voffA); PG8_STAGE(PG8_SB(1, 1), cB + hstep + kstep, voffB);
        PG8_WAIT_V(6); PG8_BAR;
    } else {
        PG8_STAGE(PG8_SB(0, 0), cB, voffB); PG8_STAGE(PG8_SA(0, 0), cA, voffA); PG8_STAGE(PG8_SB(0, 1), cB + hstep, voffB); PG8_STAGE(PG8_SA(0, 1), cA + hstep, voffA);
        if (wr == 1) PG8_BAR;
        PG8_WAIT_V(4); PG8_BAR;
        PG8_STAGE(PG8_SB(1, 0), cB + kstep, voffB); PG8_STAGE(PG8_SA(1, 0), cA + kstep, voffA); PG8_STAGE(PG8_SB(1, 1), cB + hstep + kstep, voffB);
        PG8_WAIT_V(6); PG8_BAR;
    }
    for (;;) {
        const bool has_next = S.next(ui + 1, nxt);
        const char* nA = has_next ? (const char*)g.A + (size_t)nxt.pm * tstep : cA; const char* nB = has_next ? (const char*)g.Bt + (size_t)nxt.pn * tstep : cB;
        for (int t = 0; t < nt; t += 2) {
            const bool last = (t == nt - 2);
            const char* a1 = cA + (size_t)(t + 1) * kstep;
            const char* a2 = last ? nA : cA + (size_t)(t + 2) * kstep; const char* b2 = last ? nB : cB + (size_t)(t + 2) * kstep;
            const char* a3 = a2 + kstep; const char* b3 = b2 + kstep;
            if (last && has_next) S.a_ready(nxt);
            if constexpr (SP2) {
            PG8_LDB(B0, 0, 0); PG8_LDB(B1, 0, 1); PG8_SCHED; PG8_LDA(At, 0, 0); PG8_STAGE(PG8_SA(1, 1), a1 + hstep, voffA);
            PG8_WAIT_V(8); PG8_WAIT_L(0); PG8_BAR; PG8_MMA(0, 0, At, B0); PG8_MMA(0, 1, At, B1); PG8_BAR; PG8_SCHED;
            PG8_LDA(At, 0, 1); PG8_STAGE(PG8_SB(0, 0), b2, voffB); PG8_STAGE(PG8_SB(0, 1), b2 + hstep, voffB); PG8_STAGE(PG8_SA(0, 0), a2, voffA);
            PG8_WAIT_V(8); PG8_WAIT_L(0); PG8_BAR; PG8_MMA(1, 0, At, B0); PG8_MMA(1, 1, At, B1); PG8_BAR; PG8_SCHED;
            PG8_LDB(B0, 1, 0); PG8_LDB(B1, 1, 1); PG8_SCHED; PG8_LDA(At, 1, 0); PG8_STAGE(PG8_SA(0, 1), a2 + hstep, voffA);
            PG8_WAIT_V(8); PG8_WAIT_L(0); PG8_BAR; PG8_MMA(0, 0, At, B0); PG8_MMA(0, 1, At, B1); PG8_BAR; PG8_SCHED;
            PG8_LDA(At, 1, 1); PG8_STAGE(PG8_SB(1, 0), b3, voffB); PG8_STAGE(PG8_SB(1, 1), b3 + hstep, voffB); PG8_STAGE(PG8_SA(1, 0), a3, voffA);
            PG8_WAIT_V(8); PG8_WAIT_L(0); PG8_BAR; PG8_MMA(1, 0, At, B0); PG8_MMA(1, 1, At, B1); PG8_BAR; PG8_SCHED;
            } else {
            PG8_LDB(B0, 0, 0); PG8_SCHED; PG8_LDA(At, 0, 0); PG8_STAGE(PG8_SA(1, 1), a1 + hstep, voffA);
            PG8_WAIT_L(8); PG8_BAR; PG8_WAIT_L(0); PG8_MMA(0, 0, At, B0); PG8_BAR; PG8_SCHED;
            PG8_LDB(B1, 0, 1); PG8_STAGE(PG8_SB(0, 0), b2, voffB);
            PG8_BAR; PG8_WAIT_L(0); PG8_MMA(0, 1, At, B1); PG8_BAR;
            PG8_LDA(At, 0, 1); PG8_STAGE(PG8_SA(0, 0), a2, voffA);
            PG8_BAR; PG8_WAIT_L(0); PG8_MMA(1, 0, At, B0); PG8_BAR; PG8_SCHED;
            PG8_STAGE(PG8_SB(0, 1), b2 + hstep, voffB);
            PG8_WAIT_V(6); PG8_BAR; PG8_MMA(1, 1, At, B1); PG8_BAR;
            PG8_LDB(B0, 1, 0); PG8_SCHED; PG8_LDA(At, 1, 0); PG8_STAGE(PG8_SA(0, 1), a2 + hstep, voffA);
            PG8_WAIT_L(8); PG8_BAR; PG8_WAIT_L(0); PG8_MMA(0, 0, At, B0); PG8_BAR; PG8_SCHED;
            PG8_LDB(B1, 1, 1); PG8_STAGE(PG8_SB(1, 0), b3, voffB);
            PG8_BAR; PG8_WAIT_L(0); PG8_MMA(0, 1, At, B1); PG8_BAR;
            PG8_LDA(At, 1, 1); PG8_STAGE(PG8_SA(1, 0), a3, voffA);
            PG8_BAR; PG8_WAIT_L(0); PG8_MMA(1, 0, At, B0); PG8_BAR; PG8_SCHED;
            PG8_STAGE(PG8_SB(1, 1), b3 + hstep, voffB);
            PG8_WAIT_V(6); PG8_BAR; PG8_MMA(1, 1, At, B1); PG8_BAR;
            }
        }
        if constexpr (ALIGN_EPI) { if (wr == 0) PG8_BAR; }
        if constexpr (!Epi::AFTER_DRAIN) { E(acc, cur, wr, wc, fr, fq); S.done(cur); }
        if (!has_next) break;
#pragma unroll
        for (int a = 0; a < 2; ++a)
#pragma unroll
            for (int b = 0; b < 2; ++b)
#pragma unroll
                for (int m = 0; m < 4; ++m)
#pragma unroll
                    for (int n = 0; n < 2; ++n) acc[a][b][m][n] = (f32x4){0.f, 0.f, 0.f, 0.f};
        cur = nxt; cA = nA; cB = nB; ++ui;
        if constexpr (ALIGN_EPI) { if (wr == 1) PG8_BAR; }
    }
    PG8_WAIT_V(0);
    if constexpr (!ALIGN_EPI) { if (wr == 0) PG8_BAR; }
    PG8_BAR;
    if constexpr (Epi::AFTER_DRAIN) { E.fused(acc, cur, wr, wc, fr, fq, lds, wid, lane); S.done(cur); }
#undef PG8_SA
#undef PG8_SB
#undef PG8_STAGE
#undef PG8_LDA
#undef PG8_LDB
#undef PG8_MMA
#undef PG8_WAIT_V
#undef PG8_WAIT_L
#undef PG8_BAR
#undef PG8_SCHED
}
}
using pg8::bf16_t; using pg8::bf16x8; using pg8::f32x4;
typedef float f32x16 __attribute__((ext_vector_type(16)));
typedef unsigned u32x4 __attribute__((ext_vector_type(4)));
typedef unsigned u32x2 __attribute__((ext_vector_type(2)));
typedef short s16x4 __attribute__((ext_vector_type(4)));
#define LAS __attribute__((address_space(3)))
constexpr int MP = 16384, MS = 128, MT = 16512, D = 1024, FF = 2816, NGU = 5632, NIN = 1280, NRKVL = 3328, NWAG = 3072;
constexpr int SEQ = 4096, NB_P = 4, NB_S = 8, LS = 16;
constexpr size_t MiB = 1u << 20;
constexpr size_t WE_GU0 = 0, WE_DN0 = WE_GU0 + (size_t)NGU * D, WE_GU1 = WE_DN0 + (size_t)D * FF, WE_DN1 = WE_GU1 + (size_t)NGU * D, WE_MIX = WE_DN1 + (size_t)D * FF;
constexpr size_t WE_IN = WE_MIX, WE_OUT = WE_IN + (size_t)NIN * D;
constexpr size_t WE_RKVL = WE_MIX, WE_WAG = WE_RKVL + (size_t)NRKVL * 2048, WE_WO = WE_WAG + (size_t)NWAG * 256, WE_END = WE_WO + (size_t)D * D;
static_assert(WE_END * 2 <= 50 * MiB, "weights region");
constexpr size_t WS_W = 0, WS_XB = 50 * MiB  , WS_WEFF = 83 * MiB, WS_SS = 87 * MiB, WS_A0 = 89 * MiB, WS_B2 = 178 * MiB, WS_B3 = 286 * MiB, WS_BAR = 385 * MiB, WS_END = 386 * MiB;
constexpr size_t WS_Z = WS_A0, WS_CAT = WS_A0 + 41 * MiB, WS_HH = WS_A0, WS_LD = WS_A0;
constexpr size_t WS_R = WS_B2, WS_K = WS_B2 + 33 * MiB, WS_V = WS_B2 + 66 * MiB, WS_LORA = WS_B2 + 99 * MiB;
constexpr size_t WS_AA = WS_B3, WS_G = WS_B3 + 33 * MiB, WS_AWO = WS_B3 + 66 * MiB;
static_assert((size_t)MT * FF * 2 <= 89 * MiB && (size_t)MT * NIN * 2 <= 41 * MiB && (size_t)MT * D * 2 <= 33 * MiB && (size_t)MT * 256 * 2 <= 9 * MiB && (size_t)MT * D * 4 <= 89 * MiB, "arena");
constexpr size_t O_Y = 0, O_POOLP = 16908288, O_POOLS = 16969728, O_KP = 17092608, O_KS = 17223680, O_VP = 17485824, O_VS = 17616896, O_SHP = 17879040, O_SHS = 17887232, O_WKVP = 17903616, O_WKVS = 18427904, O_END = 19476480;
constexpr int LDS_BYTES = 131072 + 1024;
constexpr int GRID = 256;

struct Args { const float* in[37]; float* out; unsigned char* ws; int ph_lo, ph_hi; };
typedef const __attribute__((address_space(4))) Args* ArgsP;

__device__ __forceinline__ unsigned pk2(float lo, float hi) { typedef float f2 __attribute__((ext_vector_type(2))); typedef __bf16 b2 __attribute__((ext_vector_type(2))); f2 v = {lo, hi}; b2 b = __builtin_convertvector(v, b2); return __builtin_bit_cast(unsigned, b); }
__device__ __forceinline__ int mk_tid(int wave_s) { unsigned ones = ~0u; asm volatile("" : "+s"(ones)); const int lane = __builtin_amdgcn_mbcnt_hi(ones, __builtin_amdgcn_mbcnt_lo(ones, 0u)); return wave_s * 64 + lane; }
__device__ __forceinline__ float bflo(unsigned u) { return __builtin_bit_cast(float, u << 16); }
__device__ __forceinline__ float bfhi(unsigned u) { return __builtin_bit_cast(float, u & 0xffff0000u); }
__device__ __forceinline__ float sigmoidf_(float x) { return __builtin_amdgcn_rcpf(1.f + __expf(-x)); }
__device__ __forceinline__ float wave_sum(float v) {
#pragma unroll
    for (int o = 1; o < 64; o <<= 1) v += __shfl_xor(v, o);
    return v;
}
template <int CTRL> __device__ __forceinline__ float dpp_f(float v) { return __builtin_bit_cast(float, __builtin_amdgcn_update_dpp(0, __builtin_bit_cast(int, v), CTRL, 0xF, 0xF, true)); }
__device__ __forceinline__ float red8(float v) { v += dpp_f<0xB1>(v); v += dpp_f<0x4E>(v); v += dpp_f<0x141>(v); return v; }
__device__ __forceinline__ float red16(float v) { v = red8(v); v += dpp_f<0x140>(v); return v; }
__device__ __forceinline__ float ss_rstd(const float* ssrow) { const f32x4 a = *(const f32x4*)ssrow, b = *(const f32x4*)(ssrow + 4), c = *(const f32x4*)(ssrow + 8), d = *(const f32x4*)(ssrow + 12);
    const float s = ((a[0] + a[1]) + (a[2] + a[3])) + ((b[0] + b[1]) + (b[2] + b[3])) + ((c[0] + c[1]) + (c[2] + c[3])) + ((d[0] + d[1]) + (d[2] + d[3])); return rsqrtf(s * (1.f / D) + 1e-6f); }
__device__ __forceinline__ u32x4 pack8(const f32x4& a, const f32x4& b) { u32x4 w; w.x = pk2(a[0], a[1]); w.y = pk2(a[2], a[3]); w.z = pk2(b[0], b[1]); w.w = pk2(b[2], b[3]); return w; }
__device__ __forceinline__ u32x2 pack4(const f32x4& a) { u32x2 w; w.x = pk2(a[0], a[1]); w.y = pk2(a[2], a[3]); return w; }

__device__ __forceinline__ void load_xrow(const float* x, const bf16_t* xb, int m, int lane, f32x4 (&v)[4]) {
    if (m < MP) {
#pragma unroll
        for (int j = 0; j < 4; ++j) { const u32x2 o = *(const u32x2*)(xb + (size_t)m * D + 4 * lane + 256 * j); v[j] = (f32x4){bflo(o.x), bfhi(o.x), bflo(o.y), bfhi(o.y)}; } }
    else {
#pragma unroll
        for (int j = 0; j < 4; ++j) v[j] = *(const f32x4*)(x + (size_t)m * D + 4 * lane + 256 * j); }
}
#define EPI_LOOP_ROWS for (int am_ = 0; am_ < 8; ++am_)
#define EPI_AM const int ai = am_ >> 2, m = am_ & 3;
struct EpiSwiglu {
    static constexpr bool PERM = true, AFTER_DRAIN = false;
    const float* ss; bf16_t* act;
    __device__ __forceinline__ void operator()(const f32x4 (&acc)[2][2][4][2], const pg8::Unit& u, int wr, int wc, int fr, int fq) const { asm volatile("" : "+v"(fr), "+v"(fq));
#pragma unroll
        EPI_LOOP_ROWS { EPI_AM const int row = u.pm * 256 + ai * 128 + wr * 64 + m * 16 + fr; const float rstd = ss_rstd(ss + (size_t)row * 16);
#pragma unroll
            for (int bj = 0; bj < 2; ++bj) { const int col0 = u.pn * 256 + bj * 128 + wc * 32 + 8 * fq; const f32x4 g = acc[ai][bj][m][0] * rstd, up = acc[ai][bj][m][1] * rstd; f32x4 o;
#pragma unroll
                for (int j = 0; j < 4; ++j) o[j] = g[j] * sigmoidf_(g[j]) * up[j];
                *(u32x2*)(act + (size_t)row * FF + (col0 >> 1)) = pack4(o); } }
    }
};
struct EpiResid {
    static constexpr bool PERM = true, AFTER_DRAIN = false;
    bf16_t* xb; float* ssn; float scale;
    __device__ __forceinline__ void operator()(const f32x4 (&acc)[2][2][4][2], const pg8::Unit& u, int wr, int wc, int fr, int fq) const { asm volatile("" : "+v"(fr), "+v"(fq));
#pragma unroll
        for (int am_ = 0; am_ < 8; ++am_) { const int ai = am_ >> 2, m = am_ & 3; const int row = u.pm * 256 + ai * 128 + wr * 64 + m * 16 + fr; float sq = 0.f;
#pragma unroll
            for (int bj = 0; bj < 2; ++bj) { const int col0 = u.pn * 256 + bj * 128 + wc * 32 + 8 * fq; bf16_t* xp = xb + (size_t)row * D + col0; const u32x4 o = *(const u32x4*)xp;
                f32x4 x0 = {bflo(o.x), bfhi(o.x), bflo(o.y), bfhi(o.y)}, x1 = {bflo(o.z), bfhi(o.z), bflo(o.w), bfhi(o.w)}; x0 += acc[ai][bj][m][0] * scale; x1 += acc[ai][bj][m][1] * scale;
                *(u32x4*)xp = pack8(x0, x1);
                sq += (x0[0] * x0[0] + x0[1] * x0[1]) + (x0[2] * x0[2] + x0[3] * x0[3]) + (x1[0] * x1[0] + x1[1] * x1[1]) + (x1[2] * x1[2] + x1[3] * x1[3]); }
            sq += __shfl_xor(sq, 16); sq += __shfl_xor(sq, 32);
            if (fq == 0) ssn[(size_t)row * 16 + u.pn * 4 + wc] = sq; }
    }
};
struct EpiZ {
    static constexpr bool PERM = true, AFTER_DRAIN = false;
    const float* ss; bf16_t* z;
    __device__ __forceinline__ void operator()(const f32x4 (&acc)[2][2][4][2], const pg8::Unit& u, int wr, int wc, int fr, int fq) const { asm volatile("" : "+v"(fr), "+v"(fq));
#pragma unroll
        EPI_LOOP_ROWS { EPI_AM const int row = u.pm * 256 + ai * 128 + wr * 64 + m * 16 + fr; const float rstd = ss_rstd(ss + (size_t)row * 16);
#pragma unroll
            for (int bj = 0; bj < 2; ++bj) { const int col0 = u.pn * 256 + bj * 128 + wc * 32 + 8 * fq;
                *(u32x4*)(z + (size_t)row * NIN + col0) = pack8(acc[ai][bj][m][0] * rstd, acc[ai][bj][m][1] * rstd); } }
    }
};
__device__ __forceinline__ float lora_act(float v, int c) { return c < 64 ? (1.f - 2.f * __builtin_amdgcn_rcpf(__expf(2.f * v) + 1.f)) : (c < 128 ? v : sigmoidf_(v)); }
struct EpiRkvl {
    static constexpr bool PERM = true, AFTER_DRAIN = false;
    bf16_t* rkv; size_t stride; bf16_t* lora;
    __device__ __forceinline__ void operator()(const f32x4 (&acc)[2][2][4][2], const pg8::Unit& u, int wr, int wc, int fr, int fq) const { asm volatile("" : "+v"(fr), "+v"(fq));
        const int t = u.pn >> 2; const int rb = u.pm * 256 + wr * 64 + fr, cb = wc * 32 + 8 * fq;
        if (t < 3) { bf16_t* base = rkv + t * stride + (size_t)rb * D + (u.pn & 3) * 256 + cb;
#pragma unroll
            for (int am_ = 0; am_ < 8; ++am_) { const int ai = am_ >> 2, m = am_ & 3;
#pragma unroll
                for (int bj = 0; bj < 2; ++bj) *(u32x4*)(base + (size_t)(ai * 128 + m * 16) * D + bj * 128) = pack8(acc[ai][bj][m][0], acc[ai][bj][m][1]); }
        } else { bf16_t* base = lora + (size_t)rb * 256 + cb;
#pragma unroll
            for (int am_ = 0; am_ < 8; ++am_) { const int ai = am_ >> 2, m = am_ & 3;
#pragma unroll
                for (int bj = 0; bj < 2; ++bj) { f32x4 a = acc[ai][bj][m][0], b = acc[ai][bj][m][1]; const int cl = bj * 128 + cb;
#pragma unroll
                    for (int j = 0; j < 4; ++j) { a[j] = lora_act(a[j], cl); b[j] = lora_act(b[j], cl); }
                    *(u32x4*)(base + (size_t)(ai * 128 + m * 16) * 256 + bj * 128) = pack8(a, b); } }
        }
    }
};
__device__ __forceinline__ float wag_w(float v) { const float y = -v; const float sp = fmaxf(y, 0.f) + __logf(1.f + __expf(-fabsf(y))); return -__expf(-sp - 0.5f); }
struct EpiWag {
    static constexpr bool PERM = true, AFTER_DRAIN = false;
    const float* w0; const float* a0; float* ld; bf16_t* aa; bf16_t* gg;
    __device__ __forceinline__ void operator()(const f32x4 (&acc)[2][2][4][2], const pg8::Unit& u, int wr, int wc, int fr, int fq) const { asm volatile("" : "+v"(fr), "+v"(fq));
        const int t = u.pn >> 2; const int cb = (u.pn & 3) * 256 + wc * 32 + 8 * fq; const int rb = u.pm * 256 + wr * 64 + fr;
        if (t == 0) {
#pragma unroll
            for (int bj = 0; bj < 2; ++bj) { const int c = cb + bj * 128; const f32x4 b0 = *(const f32x4*)(w0 + c), b1 = *(const f32x4*)(w0 + c + 4);
#pragma unroll
                for (int am_ = 0; am_ < 8; ++am_) { const int ai = am_ >> 2, m = am_ & 3; const int row = rb + ai * 128 + m * 16; f32x4 a = acc[ai][bj][m][0], b = acc[ai][bj][m][1];
#pragma unroll
                    for (int j = 0; j < 4; ++j) { a[j] = wag_w(a[j] + b0[j]); b[j] = wag_w(b[j] + b1[j]); }
                    *(f32x4*)(ld + (size_t)row * D + c) = a; *(f32x4*)(ld + (size_t)row * D + c + 4) = b; } }
        } else if (t == 1) {
#pragma unroll
            for (int bj = 0; bj < 2; ++bj) { const int c = cb + bj * 128; const f32x4 b0 = *(const f32x4*)(a0 + c), b1 = *(const f32x4*)(a0 + c + 4);
#pragma unroll
                for (int am_ = 0; am_ < 8; ++am_) { const int ai = am_ >> 2, m = am_ & 3; const int row = rb + ai * 128 + m * 16; f32x4 a = acc[ai][bj][m][0], b = acc[ai][bj][m][1];
#pragma unroll
                    for (int j = 0; j < 4; ++j) { a[j] = sigmoidf_(a[j] + b0[j]); b[j] = sigmoidf_(b[j] + b1[j]); }
                    *(u32x4*)(aa + (size_t)row * D + c) = pack8(a, b); } }
        } else {
#pragma unroll
            for (int bj = 0; bj < 2; ++bj) { const int c = cb + bj * 128;
#pragma unroll
                for (int am_ = 0; am_ < 8; ++am_) { const int ai = am_ >> 2, m = am_ & 3; const int row = rb + ai * 128 + m * 16;
                    *(u32x4*)(gg + (size_t)row * D + c) = pack8(acc[ai][bj][m][0], acc[ai][bj][m][1]); } }
        }
    }
};
#define MFMA16(a, b, c) __builtin_amdgcn_mfma_f32_16x16x32_bf16((a), (b), (c), 0, 0, 0)
struct ALbf16 { const bf16_t* A; int lda;
    __device__ __forceinline__ bf16x8 load(int row, int k, float& sq) const { return *(const bf16x8*)(A + (size_t)row * lda + k); } };
struct ALx { const float* x;
    __device__ __forceinline__ bf16x8 load(int row, int k, float& sq) const { const f32x4 a = *(const f32x4*)(x + (size_t)row * D + k), b = *(const f32x4*)(x + (size_t)row * D + k + 4);
        sq += (a[0] * a[0] + a[1] * a[1]) + (a[2] * a[2] + a[3] * a[3]) + (b[0] * b[0] + b[1] * b[1]) + (b[2] * b[2] + b[3] * b[3]); return __builtin_bit_cast(bf16x8, pack8(a, b)); } };
template <int NB, class AL, class EP>
__device__ __forceinline__ void sgemm(int tid, int wg_lo, int ntile, int ksplit, int Kc, const bf16_t* Bt, int ldb, const AL al, const EP ep) {
    const int lane = tid & 63, w = tid >> 6, fr = lane & 15, fq = lane >> 4, row = 16 * w + fr;
    if ((int)blockIdx.x < wg_lo) return;
    for (int t = GRID - 1 - blockIdx.x; t < ntile * ksplit; t += GRID - wg_lo) {
        const int tn = t % ntile, ks = t / ntile, kb = ks * Kc + 8 * fq;
        f32x4 acc[NB]; const bf16_t* bp[NB];
#pragma unroll
        for (int nb = 0; nb < NB; ++nb) { acc[nb] = (f32x4){0.f, 0.f, 0.f, 0.f}; bp[nb] = Bt + (size_t)ep.brow(tn, nb, fr) * ldb + kb; }
        float sq = 0.f;
#pragma unroll 8
        for (int k = 0; k < Kc; k += 32) { const bf16x8 a = al.load(row, kb + k, sq);
#pragma unroll
            for (int nb = 0; nb < NB; ++nb) { const bf16x8 b = *(const bf16x8*)(bp[nb] + k); acc[nb] = MFMA16(b, a, acc[nb]); } }
        sq += __shfl_xor(sq, 16); sq += __shfl_xor(sq, 32);
        ep(tn, row, fq, acc, sq);
    }
}
struct SEpiSwiglu { bf16_t* act;
    __device__ __forceinline__ int brow(int tn, int nb, int i) const { const int a = 32 * tn + 16 * (nb >> 1) + i; return 8 * (a >> 2) + 4 * (nb & 1) + (a & 3); }
    __device__ __forceinline__ void operator()(int tn, int row, int fq, const f32x4 (&acc)[4], float sq) const { const float rstd = rsqrtf(sq * (1.f / D) + 1e-6f);
#pragma unroll
        for (int h = 0; h < 2; ++h) { f32x4 o;
#pragma unroll
            for (int j = 0; j < 4; ++j) { const float g = acc[2 * h][j] * rstd; o[j] = g * sigmoidf_(g) * (acc[2 * h + 1][j] * rstd); }
            *(u32x2*)(act + (size_t)row * FF + 32 * tn + 16 * h + 4 * fq) = pack4(o); } } };
__device__ __forceinline__ void sgemm_resid(int tid, LAS unsigned char* lds, const bf16_t* A, const bf16_t* Bt, int K, float* x, float scale) {
    const int lane = tid & 63, w = tid >> 6, fr = lane & 15, fq = lane >> 4, Kc = K >> 3, kb = w * Kc + 8 * fq;
    LAS f32x4* part = (LAS f32x4*)lds;
    for (int t = GRID - 1 - blockIdx.x; t < 64; t += GRID) {
        f32x4 acc[8];
#pragma unroll
        for (int rb = 0; rb < 8; ++rb) acc[rb] = (f32x4){0.f, 0.f, 0.f, 0.f};
        const bf16_t* bp = Bt + (size_t)(16 * t + fr) * K + kb; const bf16_t* ap = A + (size_t)fr * K + kb;
        for (int k = 0; k < Kc; k += 128) { bf16x8 bv[4], av[4][8];
#pragma unroll
            for (int u = 0; u < 4; ++u) { const int kk = (k + 32 * u) < Kc ? (k + 32 * u) : k; bv[u] = *(const bf16x8*)(bp + kk);
#pragma unroll
                for (int rb = 0; rb < 8; ++rb) av[u][rb] = *(const bf16x8*)(ap + (size_t)(16 * rb) * K + kk); }
#pragma unroll
            for (int u = 0; u < 4; ++u) if (k + 32 * u < Kc) {
#pragma unroll
                for (int rb = 0; rb < 8; ++rb) acc[rb] = MFMA16(bv[u], av[u][rb], acc[rb]); } }
#pragma unroll
        for (int rb = 0; rb < 8; ++rb) part[(w * 8 + rb) * 64 + lane] = acc[rb];
        __syncthreads();
        { f32x4 s = part[w * 64 + lane];
#pragma unroll
            for (int ww = 1; ww < 8; ++ww) s += part[(ww * 8 + w) * 64 + lane];
            float* xp = x + (size_t)(16 * w + fr) * D + 16 * t + 4 * fq; f32x4 xv = *(const f32x4*)xp; xv += s * scale; *(f32x4*)xp = xv; }
        __syncthreads();
    }
}
struct SEpiZ { bf16_t* z;
    __device__ __forceinline__ int brow(int tn, int nb, int i) const { return 32 * tn + 16 * nb + i; }
    __device__ __forceinline__ void operator()(int tn, int row, int fq, const f32x4 (&acc)[2], float sq) const { const float rstd = rsqrtf(sq * (1.f / D) + 1e-6f);
#pragma unroll
        for (int nb = 0; nb < 2; ++nb) *(u32x2*)(z + (size_t)row * NIN + 32 * tn + 16 * nb + 4 * fq) = pack4(acc[nb] * rstd); } };
struct SEpiRkvl { bf16_t* rkv; size_t stride; bf16_t* lora;
    __device__ __forceinline__ int brow(int tn, int nb, int i) const { return 32 * tn + 16 * nb + i; }
    __device__ __forceinline__ void operator()(int tn, int row, int fq, const f32x4 (&acc)[2], float sq) const {
#pragma unroll
        for (int nb = 0; nb < 2; ++nb) { const int c = 32 * tn + 16 * nb + 4 * fq;
            if (c < 3072) *(u32x2*)(rkv + (size_t)(c >> 10) * stride + (size_t)row * D + (c & 1023)) = pack4(acc[nb]);
            else { f32x4 a = acc[nb]; const int cl = c - 3072;
#pragma unroll
                for (int j = 0; j < 4; ++j) a[j] = lora_act(a[j], cl);
                *(u32x2*)(lora + (size_t)row * 256 + cl) = pack4(a); } } } };
struct SEpiWag { const float* w0; const float* a0; float* ld; bf16_t* aa; bf16_t* gg;
    __device__ __forceinline__ int brow(int tn, int nb, int i) const { return 32 * tn + 16 * nb + i; }
    __device__ __forceinline__ void operator()(int tn, int row, int fq, const f32x4 (&acc)[2], float sq) const {
#pragma unroll
        for (int nb = 0; nb < 2; ++nb) { const int cc = 32 * tn + 16 * nb + 4 * fq, t = cc >> 10, c = cc & 1023; f32x4 a = acc[nb];
            if (t == 0) { const f32x4 b0 = *(const f32x4*)(w0 + c);
#pragma unroll
                for (int j = 0; j < 4; ++j) a[j] = wag_w(a[j] + b0[j]);
                *(f32x4*)(ld + (size_t)row * D + c) = a; }
            else if (t == 1) { const f32x4 b0 = *(const f32x4*)(a0 + c);
#pragma unroll
                for (int j = 0; j < 4; ++j) a[j] = sigmoidf_(a[j] + b0[j]);
                *(u32x2*)(aa + (size_t)row * D + c) = pack4(a); }
            else *(u32x2*)(gg + (size_t)row * D + c) = pack4(a); } } };
struct TrSpec { const float* W; int K, N; const float* ks; int ksmode; bf16_t* WT; int ldT, kofs, rowmode, rowoff; };
__device__ __forceinline__ TrSpec make_spec(ArgsP a, int l, int si) {
    TrSpec s; const int i = l >> 1; bf16_t* W = (bf16_t*)(a->ws + WS_W);
    s.ks = nullptr; s.ksmode = 0; s.kofs = 0; s.rowmode = 0; s.rowoff = 0;
    if (si < 6) { const int j = si / 3, t = si % 3; const size_t lj = (size_t)(l * 2 + j);
        if (t < 2) { s.W = (t == 0 ? a->in[9] : a->in[10]) + lj * D * FF; s.K = D; s.N = FF; s.ks = a->in[8] + lj * D; s.ksmode = 1; s.WT = W + (j ? WE_GU1 : WE_GU0); s.ldT = D; s.rowmode = 1 + t; }
        else { s.W = a->in[11] + lj * FF * D; s.K = FF; s.N = D; s.WT = W + (j ? WE_DN1 : WE_DN0); s.ldT = FF; }
        return s; }
    if ((l & 1) == 0) {
        if (si == 6) { s.W = a->in[13] + (size_t)i * D * NIN; s.K = D; s.N = NIN; s.ks = a->in[12] + l * D; s.ksmode = 1; s.WT = W + WE_IN; s.ldT = D; }
        else if (si == 7) { s.W = a->in[17] + (size_t)i * D * D + 512 * D; s.K = 512; s.N = D; s.WT = W + WE_OUT; s.ldT = D; s.kofs = 512; }
        else { s.W = (const float*)(a->ws + WS_WEFF) + (size_t)i * 512 * D; s.K = 512; s.N = D; s.WT = W + WE_OUT; s.ldT = D; }
    } else {
        if (si == 18) { s.W = a->in[35] + (size_t)i * D * D; s.K = D; s.N = D; s.WT = W + WE_WO; s.ldT = D; }
        else { const int q = (si - 6) >> 1, hi = (si - 6) & 1;
            const int n = q < 3 ? 1024 : (q < 5 ? 64 : 128);
            const float* src = q == 0 ? a->in[19] : q == 1 ? a->in[20] : q == 2 ? a->in[21] : q == 3 ? a->in[23] : q == 4 ? a->in[26] : a->in[28];
            const int mui = q == 0 ? 0 : q == 1 ? 2 : q == 2 ? 3 : q == 3 ? 1 : q == 4 ? 4 : 5;
            s.W = src + (size_t)i * D * n; s.K = D; s.N = n; s.ks = a->in[18] + (size_t)(i * 6 + mui) * D; s.ksmode = hi ? 1 : 2; s.WT = W + WE_RKVL; s.ldT = 2048; s.kofs = hi ? 1024 : 0;
            s.rowoff = q < 3 ? 1024 * q : (q == 3 ? 3072 : (q == 4 ? 3136 : 3200)); }
    }
    return s;
}
__device__ __forceinline__ void tr_item(const TrSpec& s, LAS float* scr, int item, int lane) {
    const int nblk = s.N / 32, kb = item / nblk, nb = item % nblk, k0 = 64 * kb, n0 = 32 * nb;
    f32x4 wv[8];
#pragma unroll
    for (int i = 0; i < 8; ++i) wv[i] = __builtin_nontemporal_load((const f32x4*)(s.W + (size_t)(k0 + (lane >> 3) + 8 * i) * s.N + n0 + 4 * (lane & 7)));
#pragma unroll
    for (int i = 0; i < 8; ++i) { const int kk = (lane >> 3) + 8 * i; f32x4 v = wv[i];
        if (s.ksmode) { const float m = s.ks[k0 + kk]; v = v * (s.ksmode == 1 ? m : 1.f - m); }
        LAS float* d = scr + kk * 33 + 4 * (lane & 7); d[0] = v[0]; d[1] = v[1]; d[2] = v[2]; d[3] = v[3]; }
    asm volatile("s_waitcnt lgkmcnt(0)" ::: "memory");
    const int c = lane & 7;
#pragma unroll
    for (int j = 0; j < 4; ++j) { const int n = (lane >> 3) + 8 * j; const LAS float* p = scr + (8 * c) * 33 + n; const int gn = n0 + n;
        const int drow = s.rowmode == 0 ? s.rowoff + gn : (8 * (gn >> 2) + (gn & 3) + (s.rowmode == 2 ? 4 : 0));
        u32x4 o; o.x = pk2(p[0 * 33], p[1 * 33]); o.y = pk2(p[2 * 33], p[3 * 33]); o.z = pk2(p[4 * 33], p[5 * 33]); o.w = pk2(p[6 * 33], p[7 * 33]);
        *(u32x4*)(s.WT + (size_t)drow * s.ldT + s.kofs + k0 + 8 * c) = o; }
    asm volatile("s_waitcnt lgkmcnt(0)" ::: "memory");
}
__device__ __forceinline__ void convert_layer(ArgsP a, int l, LAS unsigned char* lds, const int tid) {
    const int lane = tid & 63, wave = tid >> 6, gw = blockIdx.x * 8 + wave, NGW = GRID * 8;
    LAS float* scr = (LAS float*)(lds + wave * 16384);
    const int nspec = (l & 1) ? 19 : 9;
    int base = 0;
    for (int si = 0; si < nspec; ++si) { const TrSpec s = make_spec(a, l, si); const int items = (s.K / 64) * (s.N / 32);
        int first = gw - (base % NGW); if (first < 0) first += NGW;
        for (int it = first; it < items; it += NGW) tr_item(s, scr, it, lane);
        base += items; }
    if (l & 1) { const int i = l >> 1; bf16_t* WT = (bf16_t*)(a->ws + WS_W) + WE_WAG;
        for (int q = blockIdx.x * 512 + tid; q < NWAG * 32; q += GRID * 512) { const int n = q % NWAG, k0 = (q / NWAG) * 8, t = n >> 10, c = n & 1023;
            const float* src = nullptr; int kb = 0;
            if (t == 0 && k0 < 64) { src = a->in[24] + (size_t)i * 64 * D; kb = k0; } else if (t == 1 && k0 >= 64 && k0 < 128) { src = a->in[27] + (size_t)i * 64 * D; kb = k0 - 64; } else if (t == 2 && k0 >= 128) { src = a->in[29] + (size_t)i * 128 * D; kb = k0 - 128; }
            u32x4 o = {0u, 0u, 0u, 0u};
            if (src) { float v[8];
#pragma unroll
                for (int e = 0; e < 8; ++e) v[e] = src[(size_t)(kb + e) * D + c];
                o.x = pk2(v[0], v[1]); o.y = pk2(v[2], v[3]); o.z = pk2(v[4], v[5]); o.w = pk2(v[6], v[7]); }
            *(u32x4*)(WT + (size_t)n * 256 + k0) = o; } }
}
__device__ __forceinline__ void phase_init(ArgsP a, const int tid) {
    const int lane = tid & 63, gw = blockIdx.x * 8 + (tid >> 6), NGW = GRID * 8;
    float* x = a->out; bf16_t* xb = (bf16_t*)(a->ws + WS_XB); float* ss = (float*)(a->ws + WS_SS);
    for (int m = gw; m < MT; m += NGW) { const float* src = m < MP ? a->in[0] + (size_t)m * D : a->in[1] + (size_t)(m - MP) * D; float s = 0.f; f32x4 v[4];
#pragma unroll
        for (int j = 0; j < 4; ++j) { v[j] = *(const f32x4*)(src + 4 * lane + 256 * j); s += (v[j][0] * v[j][0] + v[j][1] * v[j][1]) + (v[j][2] * v[j][2] + v[j][3] * v[j][3]); }
        if (m < MP) { s = wave_sum(s); if (lane < 16) ss[(size_t)m * 16 + lane] = lane == 0 ? s : 0.f;
#pragma unroll
            for (int j = 0; j < 4; ++j) *(u32x2*)(xb + (size_t)m * D + 4 * lane + 256 * j) = pack4(v[j]); }
        else {
#pragma unroll
            for (int j = 0; j < 4; ++j) *(f32x4*)(x + (size_t)m * D + 4 * lane + 256 * j) = v[j]; } }
    const int gt = blockIdx.x * 512 + tid, NT = GRID * 512;
    float* weff = (float*)(a->ws + WS_WEFF);
    for (int q = gt; q < 2 * 512 * D; q += 2 * NT) {
        const int q1 = q + NT; float acc0 = 0.f, acc1 = 0.f;
        const int i0 = q >> 19, k0 = (q >> 10) & 511, n0 = q & 1023, g0 = k0 >> 7, i1 = q1 >> 19, k1 = (q1 >> 10) & 511, n1 = q1 & 1023, g1 = k1 >> 7;
        const float* pw0 = a->in[14] + ((size_t)(i0 * 4 + g0) * 128 + (k0 & 127)) * 128; const float* ps0 = a->in[15] + i0 * 512 + g0 * 128; const float* wo0 = a->in[17] + (size_t)i0 * D * D + (size_t)(g0 * 128) * D + n0;
        const float* pw1 = a->in[14] + ((size_t)(i1 * 4 + g1) * 128 + (k1 & 127)) * 128; const float* ps1 = a->in[15] + i1 * 512 + g1 * 128; const float* wo1 = a->in[17] + (size_t)i1 * D * D + (size_t)(g1 * 128) * D + n1;
        for (int d0 = 0; d0 < 128; d0 += 16) { float w0[16], w1[16];
#pragma unroll
            for (int e = 0; e < 16; ++e) { w0[e] = wo0[(size_t)(d0 + e) * D]; w1[e] = wo1[(size_t)(d0 + e) * D]; }
#pragma unroll
            for (int e = 0; e < 16; ++e) { acc0 += pw0[d0 + e] * ps0[d0 + e] * w0[e]; acc1 += pw1[d0 + e] * ps1[d0 + e] * w1[e]; } }
        weff[q] = acc0; weff[q1] = acc1; }
}
__device__ __forceinline__ void phase_final(ArgsP a, const int tid) {
    const int lane = tid & 63, gw = blockIdx.x * 8 + (tid >> 6), NGW = GRID * 8; float* x = a->out; const float* gn = a->in[36]; const bf16_t* xbp = (const bf16_t*)(a->ws + WS_XB);
    for (int m = 2 * gw; m < MT; m += 2 * NGW) { float s0 = 0.f, s1 = 0.f; f32x4 v[4], u[4];
#pragma unroll
        for (int j = 0; j < 4; ++j) { v[j] = (f32x4){0.f, 0.f, 0.f, 0.f}; u[j] = v[j]; }
        load_xrow(x, xbp, m, lane, v); load_xrow(x, xbp, m + 1, lane, u);
#pragma unroll
        for (int j = 0; j < 4; ++j) { s0 += (v[j][0] * v[j][0] + v[j][1] * v[j][1]) + (v[j][2] * v[j][2] + v[j][3] * v[j][3]); s1 += (u[j][0] * u[j][0] + u[j][1] * u[j][1]) + (u[j][2] * u[j][2] + u[j][3] * u[j][3]); }
        const float r0 = rsqrtf(wave_sum(s0) * (1.f / D) + 1e-6f), r1 = rsqrtf(wave_sum(s1) * (1.f / D) + 1e-6f);
#pragma unroll
        for (int j = 0; j < 4; ++j) { const f32x4 g = *(const f32x4*)(gn + 4 * lane + 256 * j); *(f32x4*)(x + (size_t)m * D + 4 * lane + 256 * j) = v[j] * r0 * g; *(f32x4*)(x + (size_t)(m + 1) * D + 4 * lane + 256 * j) = u[j] * r1 * g; } }
}
__device__ __forceinline__ void shift_store(ArgsP a, int i, size_t m, int c, const f32x4& h, const f32x4& hp) {
    bf16_t* hh = (bf16_t*)(a->ws + WS_HH); *(u32x2*)(hh + m * 2048 + c) = pack4(h); *(u32x2*)(hh + m * 2048 + 1024 + c) = pack4(hp);
}
__device__ __forceinline__ void phase_shift(ArgsP a, int l, const int tid) {
    const int i = l >> 1, lane = tid & 63, gw = blockIdx.x * 8 + (tid >> 6), NGW = GRID * 8;
    const float* x = a->out; const float* gn = a->in[12] + l * D; const bf16_t* xbp = (const bf16_t*)(a->ws + WS_XB);
    for (int m = 2 * gw; m < MT; m += 2 * NGW) { int b, t; const bool smp = m >= MP; if (!smp) { b = m >> 12; t = m & 4095; } else { b = (m - MP) >> 4; t = (m - MP) & 15; }
        f32x4 v[4], u[4], p[4]; float s0 = 0.f, s1 = 0.f, sp = 0.f;
#pragma unroll
        for (int j = 0; j < 4; ++j) p[j] = (f32x4){0.f, 0.f, 0.f, 0.f};
        load_xrow(x, xbp, m, lane, v); load_xrow(x, xbp, m + 1, lane, u); if (t > 0) load_xrow(x, xbp, m - 1, lane, p);
#pragma unroll
        for (int j = 0; j < 4; ++j) { s0 += (v[j][0] * v[j][0] + v[j][1] * v[j][1]) + (v[j][2] * v[j][2] + v[j][3] * v[j][3]); s1 += (u[j][0] * u[j][0] + u[j][1] * u[j][1]) + (u[j][2] * u[j][2] + u[j][3] * u[j][3]); sp += (p[j][0] * p[j][0] + p[j][1] * p[j][1]) + (p[j][2] * p[j][2] + p[j][3] * p[j][3]); }
        const float r0 = rsqrtf(wave_sum(s0) * (1.f / D) + 1e-6f), r1 = rsqrtf(wave_sum(s1) * (1.f / D) + 1e-6f), rp = rsqrtf(wave_sum(sp) * (1.f / D) + 1e-6f);
#pragma unroll
        for (int j = 0; j < 4; ++j) { const int c = 4 * lane + 256 * j; const f32x4 g = *(const f32x4*)(gn + c); const f32x4 h0 = v[j] * r0 * g, h1 = u[j] * r1 * g; f32x4 hp;
            if (t > 0) hp = p[j] * rp * g; else if (smp) hp = *(const f32x4*)(a->in[5] + (size_t)(i * NB_S + b) * D + c); else hp = (f32x4){0.f, 0.f, 0.f, 0.f};
            shift_store(a, i, (size_t)m, c, h0, hp); shift_store(a, i, (size_t)m + 1, c, h1, h0);
            if (!smp && t + 1 == SEQ - 1) *(f32x4*)(a->out + O_SHP + (size_t)(i * NB_P + b) * D + c) = h1;
            if (smp && t + 1 == LS - 1) *(f32x4*)(a->out + O_SHS + (size_t)(i * NB_S + b) * D + c) = h1; } }
}
#define MFMA32(a, b, c) __builtin_amdgcn_mfma_f32_32x32x16_bf16((a), (b), (c), 0, 0, 0)
__device__ __forceinline__ int t5_bucket(int rel) { const int n = rel < 0 ? -rel : rel; const int side = rel > 0 ? 16 : 0;
    const int b = n < 8 ? n : n < 12 ? 8 : n < 16 ? 9 : n < 23 ? 10 : n < 32 ? 11 : n < 46 ? 12 : n < 64 ? 13 : n < 91 ? 14 : 15; return side + b; }
__device__ __forceinline__ void phase_attn(ArgsP a, int i, LAS unsigned char* lds, const int tid) {
    const bf16_t* z = (const bf16_t*)(a->ws + WS_Z); bf16_t* cat = (bf16_t*)(a->ws + WS_CAT);
    LAS bf16_t* Kl = (LAS bf16_t*)lds;
    LAS bf16_t* Vt = (LAS bf16_t*)(lds + 27648);
    LAS float* bl = (LAS float*)(lds + 27648 + 25600);
    const int lane = tid & 63, w = tid >> 6, r = lane & 31, h = lane >> 5;
    const float* t5 = a->in[7];
    const int vcu = ((int)blockIdx.x & 7) * (GRID >> 3) + ((int)blockIdx.x >> 3);
    const int hk = vcu & 1;
    for (int q = tid; q < 1024; q += 512) { const int g = q >> 8, ri = q & 255; bl[q] = ri < 255 ? t5[t5_bucket(ri - 191) * 8 + hk * 4 + g] : 0.f; }
    for (int u = vcu; u < 512 + 16; u += GRID) { asm volatile("" : "+s"(u));
        const bool smp = u >= 512; int b, c;
        if (!smp) { c = (u >> 1) & 63; b = u >> 7; } else { b = (u - 512) >> 1; c = 2; }
        int g, iq, qrow; if (!smp) { g = w >> 1; iq = 32 * (w & 1) + r; qrow = b * SEQ + 64 * c + iq; } else { g = (2 * w + (r >> 4)) & 3; iq = r & 15; qrow = MP + b * LS + iq; }
        const int head = hk * 4 + g;
        u32x4 kreg[3], vreg[3];
#pragma unroll
        for (int it = 0; it < 3; ++it) { const int q = tid + 512 * it, j = q >> 3, ch = q & 7; u32x4 kv = {0u, 0u, 0u, 0u}, vv = {0u, 0u, 0u, 0u};
            if (!smp) { const int t = 64 * (c - 2) + j; if (t >= 0) { const bf16_t* p = z + (size_t)(b * SEQ + t) * NIN + 1024 + hk * 64 + ch * 8; kv = *(const u32x4*)p; vv = *(const u32x4*)(p + 128); } }
            else if (j < 128) { const size_t o = ((size_t)((i * NB_S + b) * 128 + j) * 2 + hk) * 64 + ch * 8;
                kv = pack8(*(const f32x4*)(a->in[3] + o), *(const f32x4*)(a->in[3] + o + 4)); vv = pack8(*(const f32x4*)(a->in[4] + o), *(const f32x4*)(a->in[4] + o + 4)); }
            else if (j < 144) { const bf16_t* p = z + (size_t)(MP + b * LS + (j - 128)) * NIN + 1024 + hk * 64 + ch * 8; kv = *(const u32x4*)p; vv = *(const u32x4*)(p + 128); }
            kreg[it] = kv; vreg[it] = vv; }
        bf16x8 qf[4];
#pragma unroll
        for (int s = 0; s < 4; ++s) qf[s] = *(const bf16x8*)(z + (size_t)qrow * NIN + 512 + head * 64 + 16 * s + 8 * h);
#pragma unroll
        for (int it = 0; it < 3; ++it) { const int q = tid + 512 * it, j = q >> 3, ch = q & 7; const u32x4 vv = vreg[it];
            *(LAS u32x4*)(Kl + j * 72 + ch * 8) = kreg[it];
            LAS bf16_t* vp = Vt + (ch * 8) * 200 + j;
            vp[0] = (bf16_t)(vv.x & 0xffffu); vp[200] = (bf16_t)(vv.x >> 16); vp[400] = (bf16_t)(vv.y & 0xffffu); vp[600] = (bf16_t)(vv.y >> 16);
            vp[800] = (bf16_t)(vv.z & 0xffffu); vp[1000] = (bf16_t)(vv.z >> 16); vp[1200] = (bf16_t)(vv.w & 0xffffu); vp[1400] = (bf16_t)(vv.w >> 16); }
        __syncthreads();
        if (!smp || w < 2) {
            const float sink = a->in[16][i * 8 + head];
            f32x16 st[6];
#pragma unroll
            for (int kb = 0; kb < 6; ++kb) {
#pragma unroll
                for (int e = 0; e < 16; ++e) st[kb][e] = 0.f;
#pragma unroll
                for (int s = 0; s < 4; ++s) { const bf16x8 kf = *(const LAS bf16x8*)(Kl + (32 * kb + r) * 72 + 16 * s + 8 * h); st[kb] = MFMA32(kf, qf[s], st[kb]); } }
            const int kmin = smp ? 0 : (c >= 2 ? 0 : 128 - 64 * c), kmax = smp ? 144 : 192;
            float mx = sink; const LAS float* blp = bl + g * 256 - iq + 63;
#pragma unroll
            for (int kb = 0; kb < 6; ++kb)
#pragma unroll
                for (int e = 0; e < 16; ++e) { const int key = 32 * kb + (e & 3) + 8 * (e >> 2) + 4 * h; float s = st[kb][e] * 0.125f + blp[key]; if (key < kmin || key >= kmax) s = -1e30f; st[kb][e] = s; mx = fmaxf(mx, s); }
            mx = fmaxf(mx, __shfl_xor(mx, 32));
            float sum = 0.f;
#pragma unroll
            for (int kb = 0; kb < 6; ++kb)
#pragma unroll
                for (int e = 0; e < 16; ++e) { const float p = __expf(st[kb][e] - mx); st[kb][e] = p; sum += p; }
            sum += __shfl_xor(sum, 32); const float inv = 1.f / (sum + __expf(sink - mx));
            f32x16 o[2];
#pragma unroll
            for (int e = 0; e < 16; ++e) { o[0][e] = 0.f; o[1][e] = 0.f; }
#pragma unroll
            for (int kb = 0; kb < 6; ++kb)
#pragma unroll
                for (int s2 = 0; s2 < 2; ++s2) { u32x4 pw; pw.x = pk2(st[kb][8 * s2], st[kb][8 * s2 + 1]); pw.y = pk2(st[kb][8 * s2 + 2], st[kb][8 * s2 + 3]); pw.z = pk2(st[kb][8 * s2 + 4], st[kb][8 * s2 + 5]); pw.w = pk2(st[kb][8 * s2 + 6], st[kb][8 * s2 + 7]);
                    const bf16x8 pf = __builtin_bit_cast(bf16x8, pw);
#pragma unroll
                    for (int db = 0; db < 2; ++db) { const LAS bf16_t* vp = Vt + (32 * db + r) * 200 + 32 * kb + 16 * s2 + 4 * h; const u32x2 lo = *(const LAS u32x2*)vp, hi = *(const LAS u32x2*)(vp + 8);
                        u32x4 vw; vw.x = lo.x; vw.y = lo.y; vw.z = hi.x; vw.w = hi.y; o[db] = MFMA32(__builtin_bit_cast(bf16x8, vw), pf, o[db]); } }
#pragma unroll
            for (int db = 0; db < 2; ++db)
#pragma unroll
                for (int rg = 0; rg < 4; ++rg) { const int d0 = 32 * db + 8 * rg + 4 * h; f32x4 v = {o[db][4 * rg] * inv, o[db][4 * rg + 1] * inv, o[db][4 * rg + 2] * inv, o[db][4 * rg + 3] * inv};
                    *(u32x2*)(cat + (size_t)qrow * D + 512 + head * 64 + d0) = pack4(v); }
        }
        __syncthreads();
    }
    const int gt = blockIdx.x * 512 + tid, NT = GRID * 512;
    for (int q = gt; q < MT * 64; q += NT) { const int m = q >> 6, c0 = (q & 63) * 8, wdw = 2 << (c0 >> 7); const bool smp = m >= MP; int b, t; if (!smp) { b = m >> 12; t = m & 4095; } else { b = (m - MP) >> 4; t = (m - MP) & 15; }
        u32x4 zz[16];
#pragma unroll
        for (int d = 0; d < 16; ++d) { const int dd = (d < wdw && t - d >= 0) ? d : 0; zz[d] = *(const u32x4*)(z + (size_t)(m - dd) * NIN + c0); }
        float s[8];
#pragma unroll
        for (int e = 0; e < 8; ++e) s[e] = 0.f;
#pragma unroll
        for (int d = 1; d < 16; ++d) { const float mk = (d < wdw && t - d >= 0) ? 1.f : 0.f;
            s[0] += mk * bflo(zz[d].x); s[1] += mk * bfhi(zz[d].x); s[2] += mk * bflo(zz[d].y); s[3] += mk * bfhi(zz[d].y); s[4] += mk * bflo(zz[d].z); s[5] += mk * bfhi(zz[d].z); s[6] += mk * bflo(zz[d].w); s[7] += mk * bfhi(zz[d].w); }
        if (smp) { for (int d = t + 1; d < wdw; ++d) { const float* hp = a->in[2] + ((size_t)(i * NB_S + b) * 15 + 15 + t - d) * 512 + c0; const f32x4 h0 = *(const f32x4*)hp, h1 = *(const f32x4*)(hp + 4);
                s[0] += h0[0]; s[1] += h0[1]; s[2] += h0[2]; s[3] += h0[3]; s[4] += h1[0]; s[5] += h1[1]; s[6] += h1[2]; s[7] += h1[3]; } }
        const float cur[8] = {bflo(zz[0].x), bfhi(zz[0].x), bflo(zz[0].y), bfhi(zz[0].y), bflo(zz[0].z), bfhi(zz[0].z), bflo(zz[0].w), bfhi(zz[0].w)};
        const float rc = 1.f / (float)(smp ? wdw : (wdw < t + 1 ? wdw : t + 1));
        f32x4 o0, o1;
#pragma unroll
        for (int e = 0; e < 4; ++e) { o0[e] = (s[e] + cur[e]) * rc - cur[e]; o1[e] = (s[4 + e] + cur[4 + e]) * rc - cur[4 + e]; }
        *(u32x4*)(cat + (size_t)m * D + c0) = pack8(o0, o1); }
    for (int q = gt; q < NB_P * 15 * 512; q += NT) { const int c = q & 511, rr = (q >> 9) % 15, b = q / (15 * 512); a->out[O_POOLP + (size_t)i * NB_P * 15 * 512 + q] = bflo((unsigned)z[(size_t)(b * SEQ + SEQ - 15 + rr) * NIN + c]); }
    for (int q = gt; q < NB_S * 15 * 512; q += NT) { const int c = q & 511, rr = (q >> 9) % 15, b = q / (15 * 512); a->out[O_POOLS + (size_t)i * NB_S * 15 * 512 + q] = bflo((unsigned)z[(size_t)(MP + b * LS + 1 + rr) * NIN + c]); }
    for (int q = gt; q < NB_P * 128 * 128; q += NT) { const int cd = q & 127, rr = (q >> 7) & 127, b = q >> 14; const bf16_t* p = z + (size_t)(b * SEQ + SEQ - 128 + rr) * NIN + 1024 + cd;
        a->out[O_KP + (size_t)i * NB_P * 16384 + q] = bflo((unsigned)p[0]); a->out[O_VP + (size_t)i * NB_P * 16384 + q] = bflo((unsigned)p[128]); }
    for (int q = gt; q < NB_S * 128 * 128; q += NT) { const int cd = q & 127, rr = (q >> 7) & 127, b = q >> 14; float kv, vv;
        if (rr < 112) { const size_t o = ((size_t)(i * NB_S + b) * 128 + rr + 16) * 128 + cd; kv = a->in[3][o]; vv = a->in[4][o]; }
        else { const bf16_t* p = z + (size_t)(MP + b * LS + rr - 112) * NIN + 1024 + cd; kv = bflo((unsigned)p[0]); vv = bflo((unsigned)p[128]); }
        a->out[O_KS + (size_t)i * NB_S * 16384 + q] = kv; a->out[O_VS + (size_t)i * NB_S * 16384 + q] = vv; }
}
constexpr int SC_BUF = 32768, SC_YB = 2 * SC_BUF, SC_ARR = 2048;
struct ScanRaw { u32x4 r2, k2, v2, a2; f32x4 l0, l1; };
__device__ __forceinline__ void scan_load(ArgsP a, ScanRaw& R, int pt, int m0, int T, int hd) {
    const int ts = pt >> 3, c8 = (pt & 7) * 8;
    if (ts < T) { const size_t m = (size_t)(m0 + ts); const int hc = hd * 64 + c8; unsigned char* ws = a->ws;
        R.r2 = *(const u32x4*)((const bf16_t*)(ws + WS_R) + m * D + hc); R.k2 = *(const u32x4*)((const bf16_t*)(ws + WS_K) + m * D + hc); R.v2 = *(const u32x4*)((const bf16_t*)(ws + WS_V) + m * D + hc); R.a2 = *(const u32x4*)((const bf16_t*)(ws + WS_AA) + m * D + hc);
        R.l0 = *(const f32x4*)((const float*)(ws + WS_LD) + m * D + hc); R.l1 = *(const f32x4*)((const float*)(ws + WS_LD) + m * D + hc + 4); }
}
__device__ __forceinline__ void scan_prep(ArgsP a, const ScanRaw& R, LAS float* buf, int pt, int m0, int T, int hd, int rq, const f32x4 (&kk8)[2], const f32x4 (&ka8)[2], const f32x4 (&rk8)[2]) {
    const int ts = pt >> 3, c8 = (pt & 7) * 8;
    if (ts < T) { const size_t m = (size_t)(m0 + ts); unsigned char* ws = a->ws;
        const u32x4 r2 = R.r2, k2 = R.k2, v2 = R.v2, a2 = R.a2; const f32x4 l0 = R.l0, l1 = R.l1;
        const f32x4 r0 = {bflo(r2.x), bfhi(r2.x), bflo(r2.y), bfhi(r2.y)}, r1 = {bflo(r2.z), bfhi(r2.z), bflo(r2.w), bfhi(r2.w)};
        const f32x4 k0 = {bflo(k2.x), bfhi(k2.x), bflo(k2.y), bfhi(k2.y)}, k1 = {bflo(k2.z), bfhi(k2.z), bflo(k2.w), bfhi(k2.w)};
        const f32x4 v0 = {bflo(v2.x), bfhi(v2.x), bflo(v2.y), bfhi(v2.y)}, v1 = {bflo(v2.z), bfhi(v2.z), bflo(v2.w), bfhi(v2.w)};
        const f32x4 a0 = {bflo(a2.x), bfhi(a2.x), bflo(a2.y), bfhi(a2.y)}, a1 = {bflo(a2.z), bfhi(a2.z), bflo(a2.w), bfhi(a2.w)};
        f32x4 q0 = k0 * kk8[0], q1 = k1 * kk8[1];
        float ssq = ((q0[0] * q0[0] + q0[1] * q0[1]) + (q0[2] * q0[2] + q0[3] * q0[3])) + ((q1[0] * q1[0] + q1[1] * q1[1]) + (q1[2] * q1[2] + q1[3] * q1[3])); ssq = red8(ssq);
        const float inv = rsqrtf(fmaxf(ssq, 1e-24f)); q0 = q0 * inv; q1 = q1 * inv;
        const f32x4 p0 = k0 * (1.f + (a0 - 1.f) * ka8[0]), p1 = k1 * (1.f + (a1 - 1.f) * ka8[1]); f32x4 d0, d1;
#pragma unroll
        for (int e = 0; e < 4; ++e) { d0[e] = __expf(l0[e]); d1[e] = __expf(l1[e]); }
        const f32x4 t0 = r0 * p0 * rk8[0], t1 = r1 * p1 * rk8[1]; float bo = ((t0[0] + t0[1]) + (t0[2] + t0[3])) + ((t1[0] + t1[1]) + (t1[2] + t1[3])); bo = red8(bo);
        { typedef __fp16 h2_t __attribute__((ext_vector_type(2)));
#define PKH(x, y) __builtin_bit_cast(unsigned, (h2_t)__builtin_amdgcn_cvt_pkrtz((x), (y)))
          const f32x4 bb0 = q0 * a0, bb1 = q1 * a1; LAS unsigned* hb = (LAS unsigned*)buf + (ts * 16 + (c8 >> 2)) * 4;
          *(LAS u32x4*)(hb) = (u32x4){PKH(-q0[0], -q0[1]), PKH(-q0[2], -q0[3]), PKH(bb0[0], bb0[1]), PKH(bb0[2], bb0[3])};
          *(LAS u32x4*)(hb + 4) = (u32x4){PKH(-q1[0], -q1[1]), PKH(-q1[2], -q1[3]), PKH(bb1[0], bb1[1]), PKH(bb1[2], bb1[3])};
          *(LAS u32x4*)(hb + SC_ARR) = (u32x4){PKH(p0[0], p0[1]), PKH(p0[2], p0[3]), PKH(r0[0], r0[1]), PKH(r0[2], r0[3])};
          *(LAS u32x4*)(hb + SC_ARR + 4) = (u32x4){PKH(p1[0], p1[1]), PKH(p1[2], p1[3]), PKH(r1[0], r1[1]), PKH(r1[2], r1[3])};
          { const f32x4 e0 = d0 - 1.f, e1 = d1 - 1.f; LAS unsigned* eb = (LAS unsigned*)buf + 2 * SC_ARR + ((ts >> 1) & 1) * 512 + ((ts >> 2) * 16 + (c8 >> 2)) * 4 + (ts & 1) * 2;
            *(LAS u32x2*)(eb) = (u32x2){PKH(e0[0], e0[1]), PKH(e0[2], e0[3])}; *(LAS u32x2*)(eb + 4) = (u32x2){PKH(e1[0], e1[1]), PKH(e1[2], e1[3])}; }
#undef PKH
          LAS float* vt = buf + 3 * SC_ARR + c8 * 32 + ts;
          vt[0] = v0[0]; vt[32] = v0[1]; vt[64] = v0[2]; vt[96] = v0[3]; vt[128] = v1[0]; vt[160] = v1[1]; vt[192] = v1[2]; vt[224] = v1[3]; }
        if (rq == 0 && (pt & 7) == 0) ((float*)(ws + WS_LORA))[m * 16 + hd] = bo; }
}
#define DPP_ADD(x, ctrl) "v_add_f32_dpp " x ", " x ", " x " " ctrl " row_mask:0xf bank_mask:0xf bound_ctrl:1\n\t"
#define MIX_SH(d, s, h, c, hi) "v_fma_mix_f32 " d ", " s ", " h ", " c " op_sel:[0," hi ",0] op_sel_hi:[0,1,0]\n\t"
#define MIX_HS(d, h, s, hi) "v_fma_mix_f32 " d ", " h ", " s ", " d " op_sel:[" hi ",0,0] op_sel_hi:[1,0,0]\n\t"
__device__ __forceinline__ void scan_step(f32x4& S, float& ypo, const u32x4& h0, const u32x4& h1, unsigned e01, unsigned e23, unsigned r01, unsigned r23, float vi) {
    float s0 = S[0], s1 = S[1], s2 = S[2], s3 = S[3], sa, yp, sb;
    asm volatile(
        MIX_SH("%[sa]", "%[s0]", "%[n01]", "0", "0") MIX_SH("%[sb]", "%[s2]", "%[n23]", "0", "0") MIX_SH("%[yp]", "%[s0]", "%[r01]", "0", "0")
        MIX_SH("%[sa]", "%[s1]", "%[n01]", "%[sa]", "1") MIX_SH("%[sb]", "%[s3]", "%[n23]", "%[sb]", "1") MIX_SH("%[yp]", "%[s1]", "%[r01]", "%[yp]", "1")
        "v_add_f32 %[sa], %[sa], %[sb]\n\t" MIX_SH("%[yp]", "%[s2]", "%[r23]", "%[yp]", "0") MIX_SH("%[yp]", "%[s3]", "%[r23]", "%[yp]", "1")
        "v_fma_mix_f32 %[s0], %[e01], %[s0], %[s0] op_sel:[0,0,0] op_sel_hi:[1,0,0]\n\t" "v_fma_mix_f32 %[s1], %[e01], %[s1], %[s1] op_sel:[1,0,0] op_sel_hi:[1,0,0]\n\t"
        DPP_ADD("%[sa]", "quad_perm:[1,0,3,2]") DPP_ADD("%[yp]", "quad_perm:[1,0,3,2]")
        "v_fma_mix_f32 %[s2], %[e23], %[s2], %[s2] op_sel:[0,0,0] op_sel_hi:[1,0,0]\n\t" "v_fma_mix_f32 %[s3], %[e23], %[s3], %[s3] op_sel:[1,0,0] op_sel_hi:[1,0,0]\n\t"
        DPP_ADD("%[sa]", "quad_perm:[2,3,0,1]") DPP_ADD("%[yp]", "quad_perm:[2,3,0,1]")
        MIX_HS("%[s0]", "%[p01]", "%[vi]", "0") MIX_HS("%[s1]", "%[p01]", "%[vi]", "1")
        DPP_ADD("%[sa]", "row_half_mirror")
        MIX_HS("%[s2]", "%[p23]", "%[vi]", "0") MIX_HS("%[s3]", "%[p23]", "%[vi]", "1")
        DPP_ADD("%[sa]", "row_mirror")
        MIX_HS("%[s0]", "%[b01]", "%[sa]", "0") MIX_HS("%[s1]", "%[b01]", "%[sa]", "1") MIX_HS("%[s2]", "%[b23]", "%[sa]", "0") "v_fma_mix_f32 %[s3], %[b23], %[sa], %[s3] op_sel:[1,0,0] op_sel_hi:[1,0,0]"
        : [s0] "+v"(s0), [s1] "+v"(s1), [s2] "+v"(s2), [s3] "+v"(s3), [sa] "=&v"(sa), [yp] "=&v"(yp), [sb] "=&v"(sb)
        : [n01] "v"(h0.x), [n23] "v"(h0.y), [b01] "v"(h0.z), [b23] "v"(h0.w), [p01] "v"(h1.x), [p23] "v"(h1.y), [r01] "v"(r01), [r23] "v"(r23),
          [e01] "v"(e01), [e23] "v"(e23), [vi] "v"(vi));
    S[0] = s0; S[1] = s1; S[2] = s2; S[3] = s3; ypo = yp;
}
__device__ __forceinline__ float h2f_lo(unsigned u) { return (float)__builtin_bit_cast(__fp16, (unsigned short)(u & 0xffffu)); }
__device__ __forceinline__ float h2f_hi(unsigned u) { return (float)__builtin_bit_cast(__fp16, (unsigned short)(u >> 16)); }
template <bool FULL, int YS> __device__ __forceinline__ void scan_chunk(f32x4& S, const LAS unsigned* hp, const LAS unsigned* ep, const LAS float* vp, LAS float* yb, int T, bool ywr) {
    unsigned rp01 = 0u, rp23 = 0u;
    const int TT = FULL ? 32 : T;
    for (int t0 = 0; t0 < TT; t0 += 4) { u32x4 h0[4], h1[4]; const f32x4 v = *(const LAS f32x4*)(vp + t0); const u32x4 ea = *(const LAS u32x4*)(ep + t0 * 16), eb = *(const LAS u32x4*)(ep + 512 + t0 * 16);
#pragma unroll
        for (int k = 0; k < 4; ++k) { h0[k] = *(const LAS u32x4*)(hp + (t0 + k) * 64); h1[k] = *(const LAS u32x4*)(hp + SC_ARR + (t0 + k) * 64);
            __builtin_amdgcn_sched_barrier(0); }
        __builtin_amdgcn_sched_barrier(0);
        const unsigned e01[4] = {ea.x, ea.z, eb.x, eb.z}, e23[4] = {ea.y, ea.w, eb.y, eb.w};
        f32x4 yp;
#pragma unroll
        for (int k = 0; k < 4; ++k) { float y1; scan_step(S, y1, h0[k], h1[k], e01[k], e23[k], k == 0 ? rp01 : h1[k - 1].z, k == 0 ? rp23 : h1[k - 1].w, v[k]); yp[k] = y1; }
        if (ywr) *(LAS f32x4*)(yb + t0) = yp;
        rp01 = h1[3].z; rp23 = h1[3].w; __builtin_amdgcn_sched_barrier(0); }
    { float yp = __builtin_fmaf(S[3], h2f_hi(rp23), __builtin_fmaf(S[2], h2f_lo(rp23), __builtin_fmaf(S[1], h2f_hi(rp01), S[0] * h2f_lo(rp01)))); yp += dpp_f<0xB1>(yp); yp += dpp_f<0x4E>(yp); if (ywr) yb[TT] = yp; }
}
#define SCAN_BAR() asm volatile("s_waitcnt lgkmcnt(0)\n\ts_barrier" ::: "memory")
__device__ __forceinline__ void phase_scan(ArgsP a, int l, LAS unsigned char* lds, const int tid) {
    const int i = l >> 1, lane = tid & 63, w = tid >> 6, pt = tid - 256;
    const int rl = lane >> 4, cq = lane & 15, rloc = 4 * (w & 3) + rl;
    LAS float* ybuf = (LAS float*)(lds + SC_YB);
    LAS float* ydummy = ybuf + 1024 + (tid & 255);
    for (int task = blockIdx.x; task < 256 + 512; task += GRID) {
        const bool smp = task >= 256; const int tk = smp ? task - 256 : task, sq = tk >> 2, rq = tk & 3, b = sq >> 4, hd = sq & 15;
        const int L = smp ? LS : SEQ, row0 = smp ? MP + b * LS : b * SEQ, nch = (L + 31) >> 5, srow = 16 * rq + rloc;
        f32x4 S = {0.f, 0.f, 0.f, 0.f};
        if (smp && w < 4) S = *(const f32x4*)(a->in[6] + ((size_t)((i * NB_S + b) * 16 + hd) * 64 + srow) * 64 + 4 * cq);
        f32x4 kk8[2], ka8[2], rk8[2];
        { const int hc = hd * 64 + ((pt & 7) * 8 & 63); kk8[0] = *(const f32x4*)(a->in[30] + i * D + hc); kk8[1] = *(const f32x4*)(a->in[30] + i * D + hc + 4); ka8[0] = *(const f32x4*)(a->in[31] + i * D + hc); ka8[1] = *(const f32x4*)(a->in[31] + i * D + hc + 4);
          rk8[0] = *(const f32x4*)(a->in[32] + i * D + hc); rk8[1] = *(const f32x4*)(a->in[32] + i * D + hc + 4); }
        bf16_t* Y = (bf16_t*)a->out;
        ScanRaw R;
        if (w >= 4) { scan_load(a, R, pt, row0, L < 32 ? L : 32, hd); scan_prep(a, R, (LAS float*)lds, pt, row0, L < 32 ? L : 32, hd, rq, kk8, ka8, rk8); if (nch > 1) scan_load(a, R, pt, row0 + 32, 32, hd); }
        SCAN_BAR();
        for (int c = 0; c < nch; ++c) { const int T = (L - 32 * c) < 32 ? (L - 32 * c) : 32;
            if (w < 4) { const LAS unsigned* hp = (const LAS unsigned*)(lds + (c & 1) * SC_BUF) + 4 * cq; const LAS unsigned* ep = (const LAS unsigned*)(lds + (c & 1) * SC_BUF) + 2 * SC_ARR + 4 * cq; const LAS float* vp = (const LAS float*)(lds + (c & 1) * SC_BUF) + 3 * SC_ARR + srow * 32; LAS float* yb = ybuf + (c & 1) * 2304 + (rloc * 4 + (cq >> 2)) * 36;
                if (L - 32 * c >= 32) scan_chunk<true, 16>(S, hp, ep, vp, yb, 32, (cq & 3) == 0); else scan_chunk<false, 16>(S, hp, ep, vp, yb, L - 32 * c, (cq & 3) == 0);
            } else {
                if (c + 1 < nch) scan_prep(a, R, (LAS float*)(lds + ((c + 1) & 1) * SC_BUF), pt, row0 + 32 * (c + 1), 32, hd, rq, kk8, ka8, rk8);
                if (c + 2 < nch) scan_load(a, R, pt, row0 + 32 * (c + 2), 32, hd);
                if (c > 0) { const int ts = pt >> 3, r2 = (pt & 7) * 2; const LAS float* yp = ybuf + ((c - 1) & 1) * 2304 + r2 * 144 + ts + 1;
                    *(unsigned*)(Y + (size_t)(row0 + 32 * (c - 1) + ts) * D + hd * 64 + 16 * rq + r2) = pk2((yp[0] + yp[36]) + (yp[72] + yp[108]), (yp[144] + yp[180]) + (yp[216] + yp[252])); }
            }
            SCAN_BAR();
        }
        if (w >= 4) { const int c = nch - 1, T = (L - 32 * c) < 32 ? (L - 32 * c) : 32, ts = pt >> 3, r2 = (pt & 7) * 2; const LAS float* yp = ybuf + (c & 1) * 2304 + r2 * 144 + ts + 1;
            if (ts < T) *(unsigned*)(Y + (size_t)(row0 + 32 * c + ts) * D + hd * 64 + 16 * rq + r2) = pk2((yp[0] + yp[36]) + (yp[72] + yp[108]), (yp[144] + yp[180]) + (yp[216] + yp[252])); }
        else { float* so = a->out + (smp ? O_WKVS + (size_t)((i * NB_S + b) * 16 + hd) * 4096 : O_WKVP + (size_t)((i * NB_P + b) * 16 + hd) * 4096) + srow * 64 + 4 * cq; *(f32x4*)so = S; }
        __syncthreads();
    }
}
__device__ __forceinline__ void phase_post(ArgsP a, int l, const int tid) {
    const int i = l >> 1; unsigned char* ws = a->ws; const bf16_t* Y = (const bf16_t*)a->out; const bf16_t* Vb = (const bf16_t*)(ws + WS_V); const bf16_t* GG = (const bf16_t*)(ws + WS_G); const float* BO = (const float*)(ws + WS_LORA); bf16_t* AWO = (bf16_t*)(ws + WS_AWO);
    const float* lw = a->in[33] + i * D; const float* lb = a->in[34] + i * D;
    const int NT = GRID * 512;
    for (int q = blockIdx.x * 512 + tid; q < MT * 256; q += 2 * NT) {
#pragma unroll
        for (int rep = 0; rep < 2; ++rep) { const int qq = q + rep * NT; if (qq < MT * 256) { const size_t m = (size_t)(qq >> 8); const int c = (qq & 255) * 4;
        const u32x2 y2 = *(const u32x2*)(Y + m * D + c), v2 = *(const u32x2*)(Vb + m * D + c), g2 = *(const u32x2*)(GG + m * D + c); const float bo = BO[m * 16 + (c >> 6)];
        const f32x4 y4 = {bflo(y2.x), bfhi(y2.x), bflo(y2.y), bfhi(y2.y)}, v4 = {bflo(v2.x), bfhi(v2.x), bflo(v2.y), bfhi(v2.y)}, g4 = {bflo(g2.x), bfhi(g2.x), bflo(g2.y), bfhi(g2.y)};
        const float mean = red16((y4[0] + y4[1]) + (y4[2] + y4[3])) * (1.f / 64.f); const f32x4 dv = y4 - mean;
        const float var = red16((dv[0] * dv[0] + dv[1] * dv[1]) + (dv[2] * dv[2] + dv[3] * dv[3])) * (1.f / 64.f); const float rs = rsqrtf(var + 64e-5f);
        const f32x4 yn = dv * rs * *(const f32x4*)(lw + c) + *(const f32x4*)(lb + c);
        *(u32x2*)(AWO + m * D + c) = pack4((yn + v4 * bo) * g4); } } }
}
#define GAS __attribute__((address_space(1)))
#define XB_TMO      128
#define XB_XCNT(j)  (256  + 64 * (j))
#define XB_XSUB(j)  (1280 + 64 * (j))
#define XB_XGEN(j)  (2304 + 64 * (j))
#define XB_TOP      3328
#define XB_TOPGEN   3392
#define XCD_BAR_WORDS 3456
#define XB_SPIN_CAP (1u << 18)

__device__ __forceinline__ unsigned xb_ld(unsigned* p)              { return __hip_atomic_load(p, __ATOMIC_RELAXED, __HIP_MEMORY_SCOPE_AGENT); }
__device__ __forceinline__ unsigned xb_add(unsigned* p, unsigned v) { return __hip_atomic_fetch_add(p, v, __ATOMIC_RELAXED, __HIP_MEMORY_SCOPE_AGENT); }
__device__ __forceinline__ unsigned xb_xcc_id() { return (unsigned)__builtin_amdgcn_s_getreg((3 << 11) | 20) & 0xFu; }
#define XB_SPIN(cond, bar) do { unsigned _sp = 0; while (cond) { __builtin_amdgcn_s_sleep(1); \
    if ((++_sp & 255u) == 0u) { if (xb_ld(&(bar)[XB_TMO])) break; if (_sp > XB_SPIN_CAP) { atomicAdd(&(bar)[XB_TMO], 1u); break; } } } } while (0)

struct XcdBarrier {
    unsigned* bar; unsigned x;
    volatile LAS unsigned* st;
};

__device__ __forceinline__ XcdBarrier xcd_barrier_post(unsigned* bar, volatile LAS unsigned* st) {
    XcdBarrier b; b.bar = bar; b.x = xb_xcc_id(); b.st = st;
    if (threadIdx.x == 0) (void)xb_add(&bar[XB_XCNT(b.x)], 1u);
    return b;
}
__device__ __forceinline__ void xcd_barrier_complete(unsigned* bar, unsigned x, unsigned& nloc, unsigned& nx) {
    const unsigned G = gridDim.x * gridDim.y * gridDim.z;
    unsigned sum, cnt, mine, sp = 0u;
    for (;;) {
        sum = 0u; cnt = 0u; mine = 0u;
#pragma unroll
        for (unsigned j = 0; j < 16; ++j) { const unsigned c = xb_ld(&bar[XB_XCNT(j)]); sum += c; cnt += (c > 0u) ? 1u : 0u; }
        mine = xb_ld(&bar[XB_XCNT(x)]);
        if (sum == G) break;
        __builtin_amdgcn_s_sleep(1);
        if ((++sp & 255u) == 0u) { if (xb_ld(&bar[XB_TMO])) break; if (sp > XB_SPIN_CAP) { atomicAdd(&bar[XB_TMO], 1u); break; } }
    }
    nloc = mine > 0u ? mine : 1u; nx = cnt > 0u ? cnt : 1u;
}

__device__ __forceinline__ void xcd_barrier(const XcdBarrier& b, const int tid0) {
    asm volatile("s_waitcnt vmcnt(0)" ::: "memory");
    __syncthreads();
    if (tid0 == 0) {
        unsigned* bar = b.bar; asm volatile("" : "+s"(bar)); unsigned bx_ = b.x; asm volatile("" : "+s"(bx_));
        __builtin_amdgcn_s_waitcnt(0);
        unsigned nloc = b.st[0], nx = b.st[1];
        if (nloc == 0u) { xcd_barrier_complete(bar, bx_, nloc, nx); b.st[0] = nloc; b.st[1] = nx; }
        const unsigned old = xb_add(&bar[XB_XSUB(bx_)], 1u);
        const unsigned gen = old / nloc;
        if (old + 1u == (gen + 1u) * nloc) {
            __builtin_amdgcn_fence(__ATOMIC_RELEASE, "agent");
            asm volatile("s_waitcnt vmcnt(0)" ::: "memory");
            const unsigned og = xb_add(&bar[XB_TOP], 1u);
            const unsigned tg = og / nx;
            if (og + 1u == (tg + 1u) * nx) xb_add(&bar[XB_TOPGEN], 1u);
            else XB_SPIN(xb_ld(&bar[XB_TOPGEN]) == tg, bar);
            __builtin_amdgcn_fence(__ATOMIC_ACQUIRE, "agent");
            xb_add(&bar[XB_XGEN(bx_)], 1u);
            asm volatile("s_waitcnt vmcnt(0)" ::: "memory");
        } else {
            XB_SPIN(xb_ld(&bar[XB_XGEN(bx_)]) == gen, bar);
            __builtin_amdgcn_fence(__ATOMIC_ACQUIRE, "agent");
            asm volatile("s_waitcnt vmcnt(0)" ::: "memory");
        }
    }
    __syncthreads();
}
#ifndef SKIP_SG
#define SKIP_SG 0
#endif
#define GEMM_P(EPI, Aptr, Bptr, NN, KK, E) do { int kk_ = (KK), nn_ = (NN); asm volatile("" : "+s"(kk_), "+s"(nn_)); pg8::Gemm g_{(const bf16_t*)(Aptr), (const bf16_t*)(Bptr), MP, nn_, kk_}; pg8::StaticOrder S_; int bid_ = blockIdx.x; asm volatile("" : "+s"(bid_)); S_.init(MP, nn_, GRID, bid_); \
    pg8::gemm_phase<EPI, pg8::StaticOrder, true, true>(lds, g_, S_, (E), mk_tid(wave_s)); } while (0)
__global__ void __launch_bounds__(512, 2) mega_fwd(Args a_unused) {
    extern __shared__ __attribute__((aligned(16))) unsigned char lds_raw[];
    LAS unsigned char* lds = (LAS unsigned char*)lds_raw;
    cg::grid_group grid = cg::this_grid();
#define GSYNC() xcd_barrier(xbar, mk_tid(wave_s))
    ArgsP a = (ArgsP)__builtin_amdgcn_kernarg_segment_ptr();
    const int wave_s = __builtin_amdgcn_readfirstlane((int)threadIdx.x >> 6);
#define RELOAD() asm volatile("" : "+s"(a))
    constexpr size_t RKV_STRIDE = (33 * MiB) / 2;
    { unsigned* bw = (unsigned*)(a->ws + WS_BAR); if (blockIdx.x == 0) for (int q = threadIdx.x; q < XCD_BAR_WORDS; q += 512) bw[q] = 0u;
      if (threadIdx.x < 64) ((LAS unsigned*)(lds + 131072))[threadIdx.x] = 0u; }
#ifndef NO_INIT
    phase_init(a, mk_tid(wave_s));
#ifdef DUP_INIT
    phase_init(a, mk_tid(wave_s)); phase_init(a, mk_tid(wave_s));
#endif
#endif
    grid.sync();
    XcdBarrier xbar = xcd_barrier_post((unsigned*)(a->ws + WS_BAR), (volatile LAS unsigned*)(lds + 131072 + 32));
    for (int l = 0; l < 4; ++l) {
        RELOAD();
#ifndef NO_CONV
        convert_layer(a, l, lds, mk_tid(wave_s));
#ifdef DUP_CONV
        GSYNC(); convert_layer(a, l, lds, mk_tid(wave_s));
#endif
#endif
        GSYNC();
        for (int part = 0; part < 3; ++part) {
            RELOAD();
            unsigned char* ws = a->ws; bf16_t* W = (bf16_t*)(ws + WS_W); float* x = a->out; bf16_t* xb = (bf16_t*)(ws + WS_XB); float* ss = (float*)(ws + WS_SS); float* xs = x + (size_t)MP * D;
            const bf16_t* rA; const bf16_t* rB; int rK, rKc; float rscale;
            if (part != 1) { const int j = part >> 1; const bf16_t* Wgu = W + (j ? WE_GU1 : WE_GU0); const float* ssk = ss + (size_t)((3 * l + part) & 1) * MP * 16; bf16_t* act = (bf16_t*)(ws + WS_A0);
                { EpiSwiglu E{ssk, act}; GEMM_P(EpiSwiglu, xb, Wgu, NGU, D, E); }
#ifdef DUP_UP
                GSYNC(); { EpiSwiglu E{ssk, act}; GEMM_P(EpiSwiglu, xb, Wgu, NGU, D, E); }
#endif
                if (!SKIP_SG) sgemm<4>(mk_tid(wave_s), 128, 88, 1, D, Wgu, D, ALx{xs}, SEpiSwiglu{act + (size_t)MP * FF});
                GSYNC();
                rA = act; rB = W + (j ? WE_DN1 : WE_DN0); rK = FF; rKc = 352; rscale = 0.5f;
            } else if ((l & 1) == 0) { const float* ssk = ss + (size_t)((3 * l + 1) & 1) * MP * 16; bf16_t* z = (bf16_t*)(ws + WS_Z);
                { EpiZ E{ssk, z}; GEMM_P(EpiZ, xb, W + WE_IN, NIN, D, E); }
                if (!SKIP_SG) sgemm<2>(mk_tid(wave_s), 64, 40, 1, D, W + WE_IN, D, ALx{xs}, SEpiZ{z + (size_t)MP * NIN});
                GSYNC();
#ifndef NO_ATTN
                phase_attn(a, l >> 1, lds, mk_tid(wave_s));
#ifdef DUP_ATTN
                GSYNC(); phase_attn(a, l >> 1, lds, mk_tid(wave_s));
#endif
#endif
                GSYNC();
                rA = (const bf16_t*)(ws + WS_CAT); rB = W + WE_OUT; rK = D; rKc = 128; rscale = 1.f;
            } else {
#ifndef NO_SHIFT
                phase_shift(a, l, mk_tid(wave_s));
#ifdef DUP_SHIFT
                GSYNC(); phase_shift(a, l, mk_tid(wave_s));
#endif
#endif
                GSYNC();
                { bf16_t* hh = (bf16_t*)(ws + WS_HH); bf16_t* rkv = (bf16_t*)(ws + WS_R); bf16_t* lora = (bf16_t*)(ws + WS_LORA);
                  { EpiRkvl E{rkv, RKV_STRIDE, lora}; GEMM_P(EpiRkvl, hh, W + WE_RKVL, NRKVL, 2048, E); }
                  if (!SKIP_SG) sgemm<2>(mk_tid(wave_s), 64, 104, 1, 2048, W + WE_RKVL, 2048, ALbf16{hh + (size_t)MP * 2048, 2048}, SEpiRkvl{rkv + (size_t)MP * D, RKV_STRIDE, lora + (size_t)MP * 256}); }
                GSYNC();
                { const int i = l >> 1; bf16_t* lora = (bf16_t*)(ws + WS_LORA); float* ldp = (float*)(ws + WS_LD); bf16_t* aa = (bf16_t*)(ws + WS_AA); bf16_t* gg = (bf16_t*)(ws + WS_G);
                  const float* w0 = a->in[22] + i * D; const float* a0 = a->in[25] + i * D;
                  { EpiWag E{w0, a0, ldp, aa, gg}; GEMM_P(EpiWag, lora, W + WE_WAG, NWAG, 256, E); }
                  if (!SKIP_SG) sgemm<2>(mk_tid(wave_s), 0, 96, 1, 256, W + WE_WAG, 256, ALbf16{lora + (size_t)MP * 256, 256}, SEpiWag{w0, a0, ldp + (size_t)MP * D, aa + (size_t)MP * D, gg + (size_t)MP * D}); }
                GSYNC();
#ifndef NO_SCAN
                phase_scan(a, l, lds, mk_tid(wave_s));
#ifdef DUP_SCAN
                GSYNC(); phase_scan(a, l, lds, mk_tid(wave_s));
#endif
#endif
                GSYNC();
                phase_post(a, l, mk_tid(wave_s));
                GSYNC();
                rA = (const bf16_t*)(ws + WS_AWO); rB = W + WE_WO; rK = D; rKc = 128; rscale = 1.f;
            }
            { EpiResid E{xb, ss + (size_t)((3 * l + part + 1) & 1) * MP * 16, rscale}; GEMM_P(EpiResid, rA, rB, D, rK, E); }
            if (!SKIP_SG) sgemm_resid(mk_tid(wave_s), lds, rA + (size_t)MP * rK, rB, rK, xs, rscale);
            GSYNC();
        }
    }
    RELOAD();
#ifndef NO_FINAL
    phase_final(a, mk_tid(wave_s));
#endif
}
extern "C" void kernel_launch(void* const* d_in, const int* in_sizes, int n_in, void* d_out, int out_size, void* d_ws, size_t ws_size, hipStream_t stream) {
    static int grid = 0;
    if (grid == 0) {
        int dev = 0, cus = 0, per_cu = 0;
        if (n_in != 37 || out_size != (int)O_END || ws_size < WS_END) { fprintf(stderr, "kernel_launch: unexpected shapes: n_in %d out %d ws %zu (need %zu)\n", n_in, out_size, ws_size, (size_t)WS_END); grid = -1; return; }
        hipGetDevice(&dev); hipDeviceGetAttribute(&cus, hipDeviceAttributeMultiprocessorCount, dev);
        if (hipFuncSetAttribute((const void*)mega_fwd, hipFuncAttributeMaxDynamicSharedMemorySize, LDS_BYTES) != hipSuccess) { fprintf(stderr, "kernel_launch: hipFuncSetAttribute failed\n"); grid = -1; return; }
        hipOccupancyMaxActiveBlocksPerMultiprocessor(&per_cu, (const void*)mega_fwd, 512, LDS_BYTES);
        (void)hipGetLastError();
        if (per_cu < 1) per_cu = 1;
        grid = GRID;
        if (cus < GRID) fprintf(stderr, "kernel_launch: device has %d CUs, kernel needs %d co-resident workgroups\n", cus, GRID);
        fprintf(stderr, "kernel_launch: cus %d per_cu %d grid %d\n", cus, per_cu, grid);
    }
    if (grid < 0) return;
    Args a{};
    for (int i = 0; i < 37; ++i) a.in[i] = (const float*)d_in[i];
    a.out = (float*)d_out; a.ws = (unsigned char*)d_ws; a.ph_lo = 0; a.ph_hi = 0;
    void* args[] = {&a};
    hipError_t e = hipLaunchCooperativeKernel((const void*)mega_fwd, dim3(grid), dim3(512), args, LDS_BYTES, stream);
    if (e != hipSuccess) fprintf(stderr, "kernel_launch: cooperative launch failed: %s\n", hipGetErrorString(e));
}
```
